# Optimizing an MI355X kernel written in HIP

```python
import jax, jax.numpy as jnp
from jax import lax
import numpy as np

D_MODEL = 1024
BATCH = 4
SEQ = 8192
DEPTH = 1

LRU_WIDTH = D_MODEL * 5 // 4
LRU_HEADS = 10
LRU_HEAD_DIM = LRU_WIDTH // LRU_HEADS
LRU_C = 8.0
LRU_CONV = 4
POOL_WIDTH = D_MODEL
POOL_WINDOWS = (2, 4, 8, 16)
POOL_GROUPS = len(POOL_WINDOWS)
POOL_GROUP_DIM = POOL_WIDTH // POOL_GROUPS
N_BRANCHES = 2
IN_WIDTH = LRU_WIDTH + POOL_WIDTH + N_BRANCHES * D_MODEL
D_FF = D_MODEL * 11 // 4
FFN_CONV = 3
RMS_EPS = 1e-6

kernel_name = "hybrid_rglru_pool_gated_merge_block"


def rms_norm(x, g):
    x32 = x.astype(jnp.float32)
    y = x32 * lax.rsqrt(jnp.mean(x32 * x32, axis=-1, keepdims=True) + RMS_EPS)
    return (y * g.astype(jnp.float32)).astype(x.dtype)


def depthwise_conv(x, w, b, left):
    k_width = w.shape[0]
    s = x.shape[1]
    xp = jnp.pad(x, ((0, 0), (left, k_width - 1 - left), (0, 0)))
    y = b
    for k in range(k_width):
        y = y + w[k] * xp[:, k:k + s]
    return y


def block_diag(x, w, b):
    bsz, s, _ = x.shape
    h, i, j = w.shape
    y = jnp.einsum('bshi,hij->bshj', x.reshape(bsz, s, h, i), w)
    return y.reshape(bsz, s, h * j) + b


def _lin_combine(left, right):
    a_l, b_l = left
    a_r, b_r = right
    return a_l * a_r, a_r * b_l + b_r


def rglru_direction(xc, wa, ba, wx, bx, lam, reverse):
    x32 = xc.astype(jnp.float32)
    r = jax.nn.sigmoid(block_diag(xc, wa, ba).astype(jnp.float32))
    i = jax.nn.sigmoid(block_diag(xc, wx, bx).astype(jnp.float32))
    log_a = -LRU_C * r * jax.nn.softplus(-lam.astype(jnp.float32))
    a = jnp.exp(log_a)
    b_in = jnp.sqrt(-jnp.expm1(2.0 * log_a)) * (i * x32)
    _, h = lax.associative_scan(_lin_combine, (a, b_in), axis=1, reverse=reverse)
    return h


def multiscale_pool(u):
    bsz, s, width = u.shape
    u32 = u.astype(jnp.float32)
    csum = jnp.concatenate([jnp.zeros((bsz, 1, width), jnp.float32),
                            jnp.cumsum(u32, axis=1)], axis=1)
    t = jnp.arange(s)
    outs = []
    for g, w in enumerate(POOL_WINDOWS):
        sl = slice(g * POOL_GROUP_DIM, (g + 1) * POOL_GROUP_DIM)
        cg = csum[..., sl]
        lo = jnp.clip(t - w // 2, 0, s - 1)
        hi = jnp.clip(t + w // 2 - 1, 0, s - 1)
        win_sum = jnp.take(cg, hi + 1, axis=1) - jnp.take(cg, lo, axis=1)
        count = (hi - lo + 1).astype(jnp.float32)[None, :, None]
        outs.append(win_sum / count - u32[..., sl])
    return jnp.concatenate(outs, axis=-1).astype(u.dtype)


def setup_inputs(seed: int = 0) -> dict:
    key = jax.random.key(seed)
    ks = jax.random.split(key, 32)
    f32 = jnp.float32
    L = DEPTH

    def nrm(k, shape, scale):
        return jax.random.normal(k, shape, f32) * scale

    def gain(k, shape):
        return 1.0 + 0.05 * jax.random.normal(k, shape, f32)

    def lru_lambda(k):
        u = jax.random.uniform(k, (L, LRU_WIDTH), f32, 0.9, 0.999)
        s = u ** (1.0 / LRU_C)
        return jnp.log(s) - jnp.log1p(-s)

    return {
        "x": jax.random.normal(ks[0], (BATCH, SEQ, D_MODEL), f32),
        "g_mix": gain(ks[1], (L, D_MODEL)),
        "w_in": nrm(ks[2], (L, D_MODEL, IN_WIDTH), D_MODEL ** -0.5),
        "b_gate": nrm(ks[3], (L, N_BRANCHES * D_MODEL), 0.01),
        "conv_a_w": nrm(ks[4], (L, LRU_CONV, LRU_WIDTH), LRU_CONV ** -0.5),
        "conv_a_b": nrm(ks[5], (L, LRU_WIDTH), 0.01),
        "wa_f": nrm(ks[6], (L, LRU_HEADS, LRU_HEAD_DIM, LRU_HEAD_DIM), LRU_HEAD_DIM ** -0.5),
        "ba_f": nrm(ks[7], (L, LRU_WIDTH), 0.01),
        "wx_f": nrm(ks[8], (L, LRU_HEADS, LRU_HEAD_DIM, LRU_HEAD_DIM), LRU_HEAD_DIM ** -0.5),
        "bx_f": nrm(ks[9], (L, LRU_WIDTH), 0.01),
        "lam_f": lru_lambda(ks[10]),
        "wa_b": nrm(ks[11], (L, LRU_HEADS, LRU_HEAD_DIM, LRU_HEAD_DIM), LRU_HEAD_DIM ** -0.5),
        "ba_b": nrm(ks[12], (L, LRU_WIDTH), 0.01),
        "wx_b": nrm(ks[13], (L, LRU_HEADS, LRU_HEAD_DIM, LRU_HEAD_DIM), LRU_HEAD_DIM ** -0.5),
        "bx_b": nrm(ks[14], (L, LRU_WIDTH), 0.01),
        "lam_b": lru_lambda(ks[15]),
        "w_pool": nrm(ks[16], (L, POOL_GROUPS, POOL_GROUP_DIM, POOL_GROUP_DIM), POOL_GROUP_DIM ** -0.5),
        "b_pool": nrm(ks[17], (L, POOL_WIDTH), 0.01),
        "pool_scale": gain(ks[18], (L, POOL_WIDTH)),
        "p_a": nrm(ks[19], (L, LRU_WIDTH, D_MODEL), LRU_WIDTH ** -0.5),
        "p_b": nrm(ks[20], (L, POOL_WIDTH, D_MODEL), POOL_WIDTH ** -0.5),
        "w_out": nrm(ks[21], (L, D_MODEL, D_MODEL), D_MODEL ** -0.5),
        "g_ffn": gain(ks[22], (L, D_MODEL)),
        "w_up": nrm(ks[23], (L, D_MODEL, 2 * D_FF), D_MODEL ** -0.5),
        "conv_f_w": nrm(ks[24], (L, FFN_CONV, 2 * D_FF), FFN_CONV ** -0.5),
        "conv_f_b": nrm(ks[25], (L, 2 * D_FF), 0.01),
        "w_down": nrm(ks[26], (L, D_FF, D_MODEL), D_FF ** -0.5),
        "g_final": gain(ks[27], (D_MODEL,)),
    }


def reference(x, g_mix, w_in, b_gate, conv_a_w, conv_a_b, wa_f, ba_f, wx_f, bx_f, lam_f,
              wa_b, ba_b, wx_b, bx_b, lam_b, w_pool, b_pool, pool_scale, p_a, p_b, w_out,
              g_ffn, w_up, conv_f_w, conv_f_b, w_down, g_final):
    for l in range(DEPTH):
        h = rms_norm(x, g_mix[l])
        proj = h @ w_in[l]
        u_a = proj[..., :LRU_WIDTH]
        u_b = proj[..., LRU_WIDTH:LRU_WIDTH + POOL_WIDTH]
        gate_logits = proj[..., LRU_WIDTH + POOL_WIDTH:] + b_gate[l]

        xa = depthwise_conv(u_a, conv_a_w[l], conv_a_b[l], LRU_CONV // 2)
        h_fwd = rglru_direction(xa, wa_f[l], ba_f[l], wx_f[l], bx_f[l], lam_f[l], False)
        h_bwd = rglru_direction(xa, wa_b[l], ba_b[l], wx_b[l], bx_b[l], lam_b[l], True)
        y_a = (h_fwd + h_bwd).astype(x.dtype) @ p_a[l]

        pooled = multiscale_pool(u_b)
        y_b = (block_diag(pooled, w_pool[l], b_pool[l]) * pool_scale[l]) @ p_b[l]

        gates = jax.nn.sigmoid(gate_logits.astype(jnp.float32)).astype(x.dtype)
        merged = gates[..., :D_MODEL] * y_a + gates[..., D_MODEL:] * y_b
        x = x + merged @ w_out[l]

        h = rms_norm(x, g_ffn[l])
        up = depthwise_conv(h @ w_up[l], conv_f_w[l], conv_f_b[l], FFN_CONV // 2)
        act = jax.nn.gelu(up[..., :D_FF], approximate=True) * up[..., D_FF:]
        x = x + act @ w_down[l]
    return rms_norm(x, g_final)
```

```cpp
#include <hip/hip_runtime.h>
#include <cstdio>
#include <cstdint>

namespace {
constexpr int NB = 4, S = 8192, D = 1024, M = NB * S;
constexpr int LW = 1280, NH = 10, HD = 128, PW = 1024, INW = 4352, FF = 2816, FF2 = 5632;
constexpr float EPS = 1e-6f;
constexpr size_t MiB = 1u << 20;

typedef unsigned short bf16;
typedef short bf16x8 __attribute__((ext_vector_type(8)));
typedef float f32x4 __attribute__((ext_vector_type(4)));

constexpr size_t OFF_WIN = 1 * MiB;
constexpr size_t OFF_WUP = 10 * MiB;
constexpr size_t OFF_WD = 21 * MiB;
constexpr size_t OFF_PA = 27 * MiB;
constexpr size_t OFF_WC = 30 * MiB;
constexpr size_t OFF_WO = 32 * MiB;
constexpr size_t OFF_WG = 34 * MiB;
constexpr size_t OFF_RS1 = 36 * MiB;
constexpr size_t OFF_RS2 = OFF_RS1 + 128 * 1024;
constexpr size_t OFF_BC = OFF_RS2 + 128 * 1024;
constexpr size_t OFF_LAMC = OFF_BC + 4096;
constexpr size_t OFF_XB = 48 * MiB;
constexpr size_t OFF_UA = 112 * MiB;
constexpr size_t OFF_UB = 192 * MiB;
constexpr size_t OFF_GT = 256 * MiB;
constexpr size_t OFF_PRE = 256 * MiB;
constexpr size_t OFF_XAB = 416 * MiB;
constexpr size_t OFF_UP = 160 * MiB;
constexpr size_t OFF_ACT = 336 * MiB;
constexpr size_t WS_NEED = 512 * MiB;

struct P { const float* in[28]; float* out; unsigned char* ws; };
enum { I_X = 0, I_GMIX, I_WIN, I_BGATE, I_CAW, I_CAB, I_WAF, I_BAF, I_WXF, I_BXF, I_LAMF, I_WAB, I_BAB, I_WXB, I_BXB, I_LAMB,
       I_WPOOL, I_BPOOL, I_PSCALE, I_PA, I_PB, I_WOUT, I_GFFN, I_WUP, I_CFW, I_CFB, I_WDOWN, I_GFINAL };

__device__ __forceinline__ float bf2f(bf16 v) { return __uint_as_float((unsigned)v << 16); }
__device__ __forceinline__ bf16 f2bf(float f) { unsigned u = __float_as_uint(f); return (bf16)((u + 0x7fffu + ((u >> 16) & 1u)) >> 16); }
__device__ __forceinline__ float sigmoidf_(float v) { return 1.0f / (1.0f + expf(-v)); }
__device__ __forceinline__ int up_orig_col(int n) { return ((n >> 7) & 1) * FF + (n >> 8) * 128 + (n & 127); }

__global__ void k_prep_w(P p) {
    const size_t tid = (size_t)blockIdx.x * blockDim.x + threadIdx.x, nth = (size_t)gridDim.x * blockDim.x;
    bf16* WinT = (bf16*)(p.ws + OFF_WIN); bf16* WupT = (bf16*)(p.ws + OFF_WUP); bf16* WdT = (bf16*)(p.ws + OFF_WD);
    bf16* PaT = (bf16*)(p.ws + OFF_PA); bf16* WcT = (bf16*)(p.ws + OFF_WC); bf16* WoT = (bf16*)(p.ws + OFF_WO); bf16* WgT = (bf16*)(p.ws + OFF_WG);
    float* bc = (float*)(p.ws + OFF_BC); float* lamc = (float*)(p.ws + OFF_LAMC);
    for (size_t i = tid; i < (size_t)INW * D; i += nth) { const int n = (int)(i / D), k = (int)(i % D); WinT[i] = f2bf(p.in[I_GMIX][k] * p.in[I_WIN][(size_t)k * INW + n]); }
    for (size_t i = tid; i < (size_t)FF2 * D; i += nth) { const int n = (int)(i / D), k = (int)(i % D); WupT[i] = f2bf(p.in[I_GFFN][k] * p.in[I_WUP][(size_t)k * FF2 + up_orig_col(n)]); }
    for (size_t i = tid; i < (size_t)D * FF; i += nth) { const int n = (int)(i / FF), k = (int)(i % FF); WdT[i] = f2bf(p.in[I_WDOWN][(size_t)k * D + n]); }
    for (size_t i = tid; i < (size_t)D * LW; i += nth) { const int n = (int)(i / LW), k = (int)(i % LW); PaT[i] = f2bf(p.in[I_PA][(size_t)k * D + n]); }
    for (size_t i = tid; i < (size_t)D * D; i += nth) { const int n = (int)(i / D), k = (int)(i % D); WoT[i] = f2bf(p.in[I_WOUT][(size_t)k * D + n]); }
    for (size_t i = tid; i < (size_t)D * PW; i += nth) { const int n = (int)(i / PW), k = (int)(i % PW); const int g = k >> 8, kk = k & 255;
        float s = 0.f; for (int j = 0; j < 256; ++j) s += p.in[I_WPOOL][(size_t)g * 65536 + kk * 256 + j] * p.in[I_PSCALE][g * 256 + j] * p.in[I_PB][(size_t)(g * 256 + j) * D + n];
        WcT[i] = f2bf(s); }
    for (size_t i = tid; i < (size_t)NH * 512 * HD; i += nth) { const int hd = (int)(i / (512 * HD)), n = (int)((i / HD) % 512), k = (int)(i % HD); const int g = n >> 7, j = n & 127;
        const float* w = p.in[g == 0 ? I_WAF : g == 1 ? I_WXF : g == 2 ? I_WAB : I_WXB]; WgT[i] = f2bf(w[(size_t)hd * HD * HD + k * HD + j]); }
    for (size_t i = tid; i < (size_t)D; i += nth) { float s = 0.f; for (int c = 0; c < PW; ++c) s += p.in[I_BPOOL][c] * p.in[I_PSCALE][c] * p.in[I_PB][(size_t)c * D + i]; bc[i] = s; }
    for (size_t i = tid; i < (size_t)2 * LW; i += nth) { const float lam = p.in[i < LW ? I_LAMF : I_LAMB][i % LW]; lamc[i] = -8.0f * log1pf(expf(-lam)); }
}

__global__ void k_xprep(P p) {
    const int row = blockIdx.x * 4 + (threadIdx.x >> 6), lane = threadIdx.x & 63;
    const f32x4* xr = (const f32x4*)(p.in[I_X] + (size_t)row * D) + lane;
    f32x4 v[4]; float s = 0.f;
    for (int j = 0; j < 4; ++j) { v[j] = xr[64 * j]; s += v[j].x * v[j].x + v[j].y * v[j].y + v[j].z * v[j].z + v[j].w * v[j].w; }
    for (int o = 1; o < 64; o <<= 1) s += __shfl_xor(s, o);
    if (lane == 0) ((float*)(p.ws + OFF_RS1))[row] = 1.0f / sqrtf(s * (1.0f / D) + EPS);
    bf16* xb = (bf16*)(p.ws + OFF_XB) + (size_t)row * D;
    for (int j = 0; j < 4; ++j) { const int c = (64 * j + lane) * 4; xb[c] = f2bf(v[j].x); xb[c + 1] = f2bf(v[j].y); xb[c + 2] = f2bf(v[j].z); xb[c + 3] = f2bf(v[j].w); }
}

__device__ __forceinline__ void ngemm_acc(f32x4 (&acc)[2][2], const bf16* A, int lda, const bf16* Bt, int ldb, int K, int row0, int col0, int lane) {
    const int fr = lane & 15, fq = lane >> 4;
    const bf16* a0 = A + (size_t)(row0 + fr) * lda + fq * 8; const bf16* a1 = a0 + (size_t)16 * lda;
    const bf16* b0 = Bt + (size_t)(col0 + fr) * ldb + fq * 8; const bf16* b1 = b0 + (size_t)16 * ldb;
    for (int k = 0; k < K; k += 32) {
        const bf16x8 va0 = *(const bf16x8*)(a0 + k), va1 = *(const bf16x8*)(a1 + k), vb0 = *(const bf16x8*)(b0 + k), vb1 = *(const bf16x8*)(b1 + k);
        acc[0][0] = __builtin_amdgcn_mfma_f32_16x16x32_bf16(va0, vb0, acc[0][0], 0, 0, 0);
        acc[0][1] = __builtin_amdgcn_mfma_f32_16x16x32_bf16(va0, vb1, acc[0][1], 0, 0, 0);
        acc[1][0] = __builtin_amdgcn_mfma_f32_16x16x32_bf16(va1, vb0, acc[1][0], 0, 0, 0);
        acc[1][1] = __builtin_amdgcn_mfma_f32_16x16x32_bf16(va1, vb1, acc[1][1], 0, 0, 0);
    }
}
#define NG_SETUP() const int lane = threadIdx.x & 63, w = threadIdx.x >> 6; const int row0 = blockIdx.y * 64 + (w >> 1) * 32, col0 = blockIdx.x * 64 + (w & 1) * 32; \
    f32x4 acc[2][2]; for (int a_ = 0; a_ < 2; ++a_) for (int b_ = 0; b_ < 2; ++b_) acc[a_][b_] = (f32x4){0.f, 0.f, 0.f, 0.f};
#define NG_FOREACH(...) for (int mi = 0; mi < 2; ++mi) for (int ni = 0; ni < 2; ++ni) for (int r = 0; r < 4; ++r) { \
    const int row = row0 + 16 * mi + 4 * (lane >> 4) + r, col = col0 + 16 * ni + (lane & 15); const float v = acc[mi][ni][r]; __VA_ARGS__ }

__global__ void __launch_bounds__(256) k_g1(P p, int colbase) {
    NG_SETUP();
    ngemm_acc(acc, (const bf16*)(p.ws + OFF_XB), D, (const bf16*)(p.ws + OFF_WIN) + (size_t)colbase * D, D, D, row0, col0, lane);
    const float* rs1 = (const float*)(p.ws + OFF_RS1);
    bf16* UA = (bf16*)(p.ws + OFF_UA); bf16* UB = (bf16*)(p.ws + OFF_UB); bf16* GT = (bf16*)(p.ws + OFF_GT);
    NG_FOREACH({ const int c = col + colbase; const float y = v * rs1[row];
        if (c < LW) UA[(size_t)row * LW + c] = f2bf(y);
        else if (c < LW + PW) UB[(size_t)row * PW + (c - LW)] = f2bf(y);
        else { const int c2 = c - LW - PW; GT[(size_t)row * 2048 + c2] = f2bf(sigmoidf_(y + p.in[I_BGATE][c2])); } });
}

__global__ void k_conv_xa(P p, int b) {
    const size_t i = (size_t)blockIdx.x * blockDim.x + threadIdx.x; if (i >= (size_t)S * LW) return;
    const int t = (int)(i / LW), c = (int)(i % LW);
    const bf16* ua = (const bf16*)(p.ws + OFF_UA) + (size_t)b * S * LW + c;
    float xa = p.in[I_CAB][c];
    for (int k = 0; k < 4; ++k) { const int tt = t + k - 2; if (tt >= 0 && tt < S) xa += p.in[I_CAW][k * LW + c] * bf2f(ua[(size_t)tt * LW]); }
    ((bf16*)(p.ws + OFF_XAB))[i] = f2bf(xa);
}

__global__ void __launch_bounds__(256) k_gates(P p) {
    NG_SETUP(); const int hd = blockIdx.z;
    ngemm_acc(acc, (const bf16*)(p.ws + OFF_XAB) + hd * HD, LW, (const bf16*)(p.ws + OFF_WG) + (size_t)hd * 512 * HD, HD, HD, row0, col0, lane);
    float* PRE = (float*)(p.ws + OFF_PRE);
    NG_FOREACH({ PRE[(size_t)row * 5120 + hd * 512 + col] = v; });
}

__global__ void k_scan(P p, int b, int dir, float* HT, bf16* Hout) {
    const int c = blockIdx.x * 64 + threadIdx.x; const int hd = c >> 7, j = c & 127;
    const float* pre = (const float*)(p.ws + OFF_PRE) + hd * 512 + (dir ? 256 : 0) + j;
    const float ba = p.in[dir ? I_BAB : I_BAF][c], bx = p.in[dir ? I_BXB : I_BXF][c], lc = ((const float*)(p.ws + OFF_LAMC))[dir * LW + c];
    const float w0 = p.in[I_CAW][c], w1 = p.in[I_CAW][LW + c], w2 = p.in[I_CAW][2 * LW + c], w3 = p.in[I_CAW][3 * LW + c], cb = p.in[I_CAB][c];
    const bf16* ua = (const bf16*)(p.ws + OFF_UA) + (size_t)b * S * LW + c;
    float h = 0.f;
#pragma unroll 4
    for (int s = 0; s < S; ++s) {
        const int t = dir ? S - 1 - s : s;
        const float pa = pre[(size_t)t * 5120], px = pre[(size_t)t * 5120 + 128];
        const float um2 = t >= 2 ? bf2f(ua[(size_t)(t - 2) * LW]) : 0.f, um1 = t >= 1 ? bf2f(ua[(size_t)(t - 1) * LW]) : 0.f, u0 = bf2f(ua[(size_t)t * LW]), up1 = t + 1 < S ? bf2f(ua[(size_t)(t + 1) * LW]) : 0.f;
        const float xa = cb + w0 * um2 + w1 * um1 + w2 * u0 + w3 * up1;
        const float r = sigmoidf_(pa + ba), ig = sigmoidf_(px + bx);
        const float la = lc * r, a = expf(la), mult = sqrtf(-expm1f(2.0f * la));
        h = a * h + mult * (ig * xa);
        if (dir) HT[(size_t)t * LW + c] = h;
        else Hout[((size_t)b * S + t) * LW + c] = f2bf(h + HT[(size_t)t * LW + c]);
    }
}

__global__ void k_pool(P p) {
    const size_t i = (size_t)blockIdx.x * blockDim.x + threadIdx.x; if (i >= (size_t)M * PW) return;
    const int row = (int)(i / PW), c = (int)(i % PW), b = row / S, t = row % S, g = c >> 8, w = 2 << g;
    const int lo = max(t - w / 2, 0), hi = min(t + w / 2 - 1, S - 1);
    const bf16* ub = (const bf16*)(p.ws + OFF_UB) + (size_t)b * S * PW + c;
    float s = 0.f; for (int q = lo; q <= hi; ++q) s += bf2f(ub[(size_t)q * PW]);
    ((bf16*)(p.ws + OFF_XB))[i] = f2bf(s / (float)(hi - lo + 1) - bf2f(ub[(size_t)t * PW]));
}

__global__ void __launch_bounds__(256) k_merge(P p, const bf16* H) {
    NG_SETUP();
    f32x4 acc2[2][2]; for (int a_ = 0; a_ < 2; ++a_) for (int b_ = 0; b_ < 2; ++b_) acc2[a_][b_] = (f32x4){0.f, 0.f, 0.f, 0.f};
    ngemm_acc(acc, H, LW, (const bf16*)(p.ws + OFF_PA), LW, LW, row0, col0, lane);
    ngemm_acc(acc2, (const bf16*)(p.ws + OFF_XB), PW, (const bf16*)(p.ws + OFF_WC), PW, PW, row0, col0, lane);
    const bf16* GT = (const bf16*)(p.ws + OFF_GT); const float* bc = (const float*)(p.ws + OFF_BC); bf16* MG = (bf16*)(p.ws + OFF_UA);
    NG_FOREACH({ const float yb = acc2[mi][ni][r] + bc[col]; const float ga = bf2f(GT[(size_t)row * 2048 + col]), gb = bf2f(GT[(size_t)row * 2048 + 1024 + col]);
        MG[(size_t)row * D + col] = f2bf(ga * v + gb * yb); });
}

__global__ void __launch_bounds__(256) k_out(P p) {
    NG_SETUP();
    ngemm_acc(acc, (const bf16*)(p.ws + OFF_UA), D, (const bf16*)(p.ws + OFF_WO), D, D, row0, col0, lane);
    bf16* X1B = (bf16*)(p.ws + OFF_XB);
    NG_FOREACH({ const float x1 = p.in[I_X][(size_t)row * D + col] + v; p.out[(size_t)row * D + col] = x1; X1B[(size_t)row * D + col] = f2bf(x1); });
}

__global__ void k_rs2(P p) {
    const int row = blockIdx.x * 4 + (threadIdx.x >> 6), lane = threadIdx.x & 63;
    const f32x4* xr = (const f32x4*)(p.out + (size_t)row * D) + lane; float s = 0.f;
    for (int j = 0; j < 4; ++j) { const f32x4 v = xr[64 * j]; s += v.x * v.x + v.y * v.y + v.z * v.z + v.w * v.w; }
    for (int o = 1; o < 64; o <<= 1) s += __shfl_xor(s, o);
    if (lane == 0) ((float*)(p.ws + OFF_RS2))[row] = 1.0f / sqrtf(s * (1.0f / D) + EPS);
}

__global__ void __launch_bounds__(256) k_up(P p, int rowbase) {
    NG_SETUP();
    ngemm_acc(acc, (const bf16*)(p.ws + OFF_XB) + (size_t)rowbase * D, D, (const bf16*)(p.ws + OFF_WUP), D, D, row0, col0, lane);
    const float* rs2 = (const float*)(p.ws + OFF_RS2) + rowbase; bf16* UP = (bf16*)(p.ws + OFF_UP);
    NG_FOREACH({ UP[(size_t)row * FF2 + col] = f2bf(v * rs2[row]); });
}

__global__ void k_act(P p, int rowbase) {
    const size_t i = (size_t)blockIdx.x * blockDim.x + threadIdx.x; if (i >= (size_t)(M / 2) * FF) return;
    const int lr = (int)(i / FF), ch = (int)(i % FF), t = (rowbase + lr) % S;
    const int gcol = (ch >> 7) * 256 + (ch & 127), vcol = gcol + 128;
    const bf16* UP = (const bf16*)(p.ws + OFF_UP);
    float g = p.in[I_CFB][ch], v = p.in[I_CFB][FF + ch];
    for (int k = 0; k < 3; ++k) { const int tt = t + k - 1; if (tt >= 0 && tt < S) { const size_t r = (size_t)(lr + k - 1) * FF2;
        g += p.in[I_CFW][k * FF2 + ch] * bf2f(UP[r + gcol]); v += p.in[I_CFW][k * FF2 + FF + ch] * bf2f(UP[r + vcol]); } }
    const float ge = 0.5f * g * (1.0f + tanhf(0.7978845608028654f * (g + 0.044715f * g * g * g)));
    ((bf16*)(p.ws + OFF_ACT))[(size_t)(rowbase + lr) * FF + ch] = f2bf(ge * v);
}

__global__ void __launch_bounds__(256) k_down(P p) {
    NG_SETUP();
    ngemm_acc(acc, (const bf16*)(p.ws + OFF_ACT), FF, (const bf16*)(p.ws + OFF_WD), FF, FF, row0, col0, lane);
    NG_FOREACH({ p.out[(size_t)row * D + col] += v; });
}

__global__ void k_final(P p) {
    const int row = blockIdx.x * 4 + (threadIdx.x >> 6), lane = threadIdx.x & 63;
    f32x4* xr = (f32x4*)(p.out + (size_t)row * D) + lane; const f32x4* gr = (const f32x4*)p.in[I_GFINAL] + lane; f32x4 v[4]; float s = 0.f;
    for (int j = 0; j < 4; ++j) { v[j] = xr[64 * j]; s += v[j].x * v[j].x + v[j].y * v[j].y + v[j].z * v[j].z + v[j].w * v[j].w; }
    for (int o = 1; o < 64; o <<= 1) s += __shfl_xor(s, o);
    const float rs = 1.0f / sqrtf(s * (1.0f / D) + EPS);
    for (int j = 0; j < 4; ++j) xr[64 * j] = v[j] * rs * gr[64 * j];
}
}

extern "C" void kernel_launch(void* const* d_in, const int* in_sizes, int n_in, void* d_out, int out_size, void* d_ws, size_t ws_size, hipStream_t stream) {
    if (n_in != 28 || out_size != M * D || ws_size < WS_NEED) { fprintf(stderr, "kernel_launch: unexpected shapes n_in %d out %d ws %zu\n", n_in, out_size, ws_size); return; }
    P p{}; for (int i = 0; i < 28; ++i) p.in[i] = (const float*)d_in[i]; p.out = (float*)d_out; p.ws = (unsigned char*)d_ws;
    float* HT = (float*)d_out + (size_t)20 * MiB;
    bf16* Hb = (bf16*)d_out;
    k_prep_w<<<2048, 256, 0, stream>>>(p);
    k_xprep<<<M / 4, 256, 0, stream>>>(p);
    k_g1<<<dim3((LW + PW) / 64, M / 64), 256, 0, stream>>>(p, 0);
    for (int b = 0; b < NB; ++b) {
        k_conv_xa<<<(S * LW + 255) / 256, 256, 0, stream>>>(p, b);
        k_gates<<<dim3(512 / 64, S / 64, NH), 256, 0, stream>>>(p);
        k_scan<<<LW / 64, 64, 0, stream>>>(p, b, 1, HT, Hb);
        k_scan<<<LW / 64, 64, 0, stream>>>(p, b, 0, HT, Hb);
    }
    k_g1<<<dim3(2048 / 64, M / 64), 256, 0, stream>>>(p, LW + PW);
    k_pool<<<(int)(((size_t)M * PW + 255) / 256), 256, 0, stream>>>(p);
    k_merge<<<dim3(D / 64, M / 64), 256, 0, stream>>>(p, Hb);
    k_out<<<dim3(D / 64, M / 64), 256, 0, stream>>>(p);
    k_rs2<<<M / 4, 256, 0, stream>>>(p);
    for (int h = 0; h < 2; ++h) {
        k_up<<<dim3(FF2 / 64, (M / 2) / 64), 256, 0, stream>>>(p, h * (M / 2));
        k_act<<<(int)(((size_t)(M / 2) * FF + 255) / 256), 256, 0, stream>>>(p, h * (M / 2));
    }
    k_down<<<dim3(D / 64, M / 64), 256, 0, stream>>>(p);
    k_final<<<M / 4, 256, 0, stream>>>(p);
}
```

```cpp
#include <hip/hip_runtime.h>
#include <cstdio>
#include <cstdint>

#ifndef MK_N_LAUNCHES
#define MK_N_LAUNCHES 13
#endif
namespace pg8 {
#define PG8_LAS __attribute__((address_space(3)))
typedef unsigned short bf16_t;
typedef short bf16x8 __attribute__((ext_vector_type(8)));
typedef float f32x4 __attribute__((ext_vector_type(4)));
typedef unsigned u32x4 __attribute__((ext_vector_type(4)));
constexpr int BM = 256, BK = 64, HALF = 128, HTB = HALF * BK * 2  , STAGE_BYTES = 8 * HTB, NXCD = 8, WGM = 8;

__host__ __device__ __forceinline__ int lds_byte(int r, int c) { const int st = (r >> 4) * 2 + (c >> 5), rr = r & 15, cc = c & 31, ob = rr * 64 + cc * 2; return st * 1024 + (ob ^ (((ob >> 9) & 1) << 5)); }
__host__ __device__ __forceinline__ void stage_rc(int b, int& R, int& C) { const int st = b / 1024, sb = b % 1024, swz = sb ^ (((sb >> 9) & 1) << 5); R = (st >> 1) * 16 + swz / 64; C = (st & 1) * 32 + (swz % 64) / 2; }
__host__ __device__ __forceinline__ int perm32(int rho) { const int n = rho >> 4, i = rho & 15; return 8 * (i >> 2) + 4 * n + (i & 3); }

struct Unit { int pm, pn; };
struct Gemm { const bf16_t* A; const bf16_t* Bt; int M, N, K; };

struct StaticOrder {
    int nM, nN, nwg, G, c;
    __host__ __device__ void init(int M, int N, int G_, int c_) { nM = M / BM; nN = N / BM; nwg = nM * nN; G = G_; c = c_; }
    __host__ __device__ bool next(int i, Unit& u) const {
        const long L = (long)i * G + c; if (L >= nwg) return false;
        int wgid = (int)L; { const int q = nwg / NXCD, r = nwg % NXCD, xcd = wgid % NXCD, off = wgid / NXCD; wgid = (xcd < r ? xcd * (q + 1) : r * (q + 1) + (xcd - r) * q) + off; }
        const int nig = WGM * nN, gid = wgid / nig, fm = gid * WGM, gsz = (nM - fm) < WGM ? (nM - fm) : WGM;
        u.pm = fm + ((wgid % nig) % gsz); u.pn = (wgid % nig) / gsz; return true;
    }
    __device__ __forceinline__ void a_ready(const Unit&) const {}
    __device__ __forceinline__ void done(const Unit&) const {}
};

__device__ __forceinline__ unsigned cvt_pk_bf16(float lo, float hi) { unsigned r; asm volatile("v_cvt_pk_bf16_f32 %0, %1, %2" : "=v"(r) : "v"(lo), "v"(hi)); return r; }
__device__ __forceinline__ float bflo(unsigned w) { return __uint_as_float(w << 16); }
__device__ __forceinline__ float bfhi(unsigned w) { return __uint_as_float(w & 0xffff0000u); }
typedef unsigned u32x2 __attribute__((ext_vector_type(2)));
constexpr float LOG2E = 1.4426950408889634f;

struct EpiG1 {
    static constexpr bool PERM = true, AFTER_DRAIN = false, HAS_MID = false; int tmid;
    bf16_t* UA; bf16_t* UB; bf16_t* RAT; bf16_t* GB; const float* rs1; const float* bgate;
    __device__ __forceinline__ void mid(f32x4 (&)[2][2][4][2], const Unit&, int, int, int, int) const {}
    __device__ __forceinline__ void operator()(const f32x4 (&acc)[2][2][4][2], const Unit& u, int wr, int wc, int fr, int fq) const {
        const int row0_ = u.pm * BM + wr * 64 + fr;
        int row0 = row0_; asm volatile("" : "+v"(row0));
        if (u.pn < 9) {
            bf16_t* base; int ldc, colt;
            if (u.pn < 5) { base = UA; ldc = 1280; colt = u.pn * 256; } else { base = UB; ldc = 1024; colt = (u.pn - 5) * 256; }
            const int col0 = colt + wc * 32 + 8 * fq;
#pragma unroll
            for (int ai = 0; ai < 2; ++ai)
#pragma unroll
                for (int m = 0; m < 4; ++m) { const int row = row0 + ai * HALF + m * 16; const float rs = rs1[row]; bf16_t* rowp = base + (size_t)row * ldc + col0;
#pragma unroll
                    for (int bj = 0; bj < 2; ++bj) { const f32x4 v0 = acc[ai][bj][m][0] * rs, v1 = acc[ai][bj][m][1] * rs;
                        u32x4 w; w.x = cvt_pk_bf16(v0[0], v0[1]); w.y = cvt_pk_bf16(v0[2], v0[3]); w.z = cvt_pk_bf16(v1[0], v1[1]); w.w = cvt_pk_bf16(v1[2], v1[3]);
                        *(u32x4*)(rowp + bj * HALF) = w; } }
        } else {
            const int ch0 = (u.pn - 9) * 128 + wc * 32 + 8 * fq;
            f32x4 ba[2], bb[2];
#pragma unroll
            for (int n = 0; n < 2; ++n) { ba[n] = *(const f32x4*)(bgate + ch0 + 4 * n) * (-LOG2E); bb[n] = *(const f32x4*)(bgate + 1024 + ch0 + 4 * n) * (-LOG2E); }
#pragma unroll
            for (int ai = 0; ai < 2; ++ai)
#pragma unroll
                for (int m = 0; m < 4; ++m) { const int row = row0 + ai * HALF + m * 16; const float rs = rs1[row] * (-LOG2E);
                    float ra[8], gb[8];
#pragma unroll
                    for (int n = 0; n < 2; ++n)
#pragma unroll
                        for (int j = 0; j < 4; ++j) { const float ea = __builtin_amdgcn_exp2f(acc[ai][0][m][n][j] * rs + ba[n][j]); const float eb = fminf(__builtin_amdgcn_exp2f(acc[ai][1][m][n][j] * rs + bb[n][j]), 1e18f);
                            gb[4 * n + j] = __builtin_amdgcn_rcpf(1.0f + eb); ra[4 * n + j] = (1.0f + eb) * __builtin_amdgcn_rcpf(1.0f + ea); }
                    u32x4 w; w.x = cvt_pk_bf16(ra[0], ra[1]); w.y = cvt_pk_bf16(ra[2], ra[3]); w.z = cvt_pk_bf16(ra[4], ra[5]); w.w = cvt_pk_bf16(ra[6], ra[7]);
                    *(u32x4*)((char*)RAT + ((unsigned)row * 1024u + (unsigned)ch0) * 2u) = w;
                    w.x = cvt_pk_bf16(gb[0], gb[1]); w.y = cvt_pk_bf16(gb[2], gb[3]); w.z = cvt_pk_bf16(gb[4], gb[5]); w.w = cvt_pk_bf16(gb[6], gb[7]);
                    *(u32x4*)((char*)GB + ((unsigned)row * 1024u + (unsigned)ch0) * 2u) = w; }
        }
    }
};

struct EpiMerge {
    static constexpr bool PERM = true, AFTER_DRAIN = false, HAS_MID = true; int tmid;
    const bf16_t* RAT; const bf16_t* GB; const float* bc; bf16_t* MG;
    __device__ __forceinline__ void mid(f32x4 (&acc)[2][2][4][2], const Unit& u, int wr, int wc, int fr, int fq) const {
        const int row0_ = u.pm * BM + wr * 64 + fr, col0 = u.pn * BM + wc * 32 + 8 * fq;
        int row0 = row0_; asm volatile("" : "+v"(row0));
#pragma unroll
        for (int ai = 0; ai < 2; ++ai)
#pragma unroll
            for (int m = 0; m < 4; ++m) { const unsigned rb = ((unsigned)(row0 + ai * HALF + m * 16) * 1024u + (unsigned)col0) * 2u;
#pragma unroll
                for (int bj = 0; bj < 2; ++bj) { const u32x4 w = *(const u32x4*)((const char*)RAT + (rb + bj * HALF * 2u));
                    acc[ai][bj][m][0] *= (f32x4){bflo(w.x), bfhi(w.x), bflo(w.y), bfhi(w.y)}; acc[ai][bj][m][1] *= (f32x4){bflo(w.z), bfhi(w.z), bflo(w.w), bfhi(w.w)}; }
                asm volatile("" ::: "memory"); }
    }
    __device__ __forceinline__ void operator()(const f32x4 (&acc)[2][2][4][2], const Unit& u, int wr, int wc, int fr, int fq) const {
        const int row0_ = u.pm * BM + wr * 64 + fr, col0 = u.pn * BM + wc * 32 + 8 * fq;
        int row0 = row0_; asm volatile("" : "+v"(row0));
        f32x4 bv[2][2];
#pragma unroll
        for (int bj = 0; bj < 2; ++bj)
#pragma unroll
            for (int n = 0; n < 2; ++n) bv[bj][n] = *(const f32x4*)(bc + col0 + bj * HALF + 4 * n);
#pragma unroll
        for (int ai = 0; ai < 2; ++ai)
#pragma unroll
            for (int m = 0; m < 4; ++m) { const unsigned rb = ((unsigned)(row0 + ai * HALF + m * 16) * 1024u + (unsigned)col0) * 2u;
#pragma unroll
                for (int bj = 0; bj < 2; ++bj) { const u32x4 g = *(const u32x4*)((const char*)GB + (rb + bj * HALF * 2u));
                    const f32x4 v0 = (acc[ai][bj][m][0] + bv[bj][0]) * (f32x4){bflo(g.x), bfhi(g.x), bflo(g.y), bfhi(g.y)}, v1 = (acc[ai][bj][m][1] + bv[bj][1]) * (f32x4){bflo(g.z), bfhi(g.z), bflo(g.w), bfhi(g.w)};
                    u32x4 w; w.x = cvt_pk_bf16(v0[0], v0[1]); w.y = cvt_pk_bf16(v0[2], v0[3]); w.z = cvt_pk_bf16(v1[0], v1[1]); w.w = cvt_pk_bf16(v1[2], v1[3]);
                    *(u32x4*)((char*)MG + (rb + bj * HALF * 2u)) = w; }
                asm volatile("" ::: "memory"); }
    }
};

template <bool WRITE_BF> struct EpiRes {
    static constexpr bool PERM = false, AFTER_DRAIN = false, HAS_MID = false; int tmid;
    const float* xin; float* out; bf16_t* XB; float* PS;
    __device__ __forceinline__ void mid(f32x4 (&)[2][2][4][2], const Unit&, int, int, int, int) const {}
    __device__ __forceinline__ void operator()(const f32x4 (&acc)[2][2][4][2], const Unit& u, int wr, int wc, int fr, int fq) const {
        const int row0_ = u.pm * BM + wr * 64 + fr, col0 = u.pn * BM + wc * 32 + 4 * fq;
        int row0 = row0_; asm volatile("" : "+v"(row0));
#pragma unroll
        for (int ai = 0; ai < 2; ++ai)
#pragma unroll
            for (int m = 0; m < 4; ++m) { const int row = row0 + ai * HALF + m * 16; const unsigned off = (unsigned)row * 1024u + (unsigned)col0; float ss = 0.f;
#pragma unroll
                for (int bj = 0; bj < 2; ++bj)
#pragma unroll
                    for (int n = 0; n < 2; ++n) { const unsigned o = off + bj * HALF + n * 16; const f32x4 x1 = *(const f32x4*)((const char*)xin + o * 4u) + acc[ai][bj][m][n]; *(f32x4*)((char*)out + o * 4u) = x1;
                        ss += (x1[0] * x1[0] + x1[1] * x1[1]) + (x1[2] * x1[2] + x1[3] * x1[3]);
                        if (WRITE_BF) { u32x2 w; w.x = cvt_pk_bf16(x1[0], x1[1]); w.y = cvt_pk_bf16(x1[2], x1[3]); *(u32x2*)((char*)XB + o * 2u) = w; } }
                ss += __shfl_xor(ss, 16); ss += __shfl_xor(ss, 32);
                if (fq == 0) PS[(size_t)row * 16 + u.pn * 4 + wc] = ss; }
    }
};

struct EpiUp {
    static constexpr bool PERM = true, AFTER_DRAIN = false, HAS_MID = false; int tmid;
    const float* PS; bf16_t* UP; int ldc;
    __device__ __forceinline__ void mid(f32x4 (&)[2][2][4][2], const Unit&, int, int, int, int) const {}
    __device__ __forceinline__ void operator()(const f32x4 (&acc)[2][2][4][2], const Unit& u, int wr, int wc, int fr, int fq) const {
        const int row0_ = u.pm * BM + wr * 64 + fr, col0 = u.pn * BM + wc * 32 + 8 * fq;
        int row0 = row0_; asm volatile("" : "+v"(row0));
#pragma unroll
        for (int ai = 0; ai < 2; ++ai)
#pragma unroll
            for (int m = 0; m < 4; ++m) { const int row = row0 + ai * HALF + m * 16; const f32x4* ps = (const f32x4*)(PS + (size_t)row * 16);
                const f32x4 s4 = (ps[0] + ps[1]) + (ps[2] + ps[3]); const float rs = 1.0f / sqrtf(((s4[0] + s4[1]) + (s4[2] + s4[3])) * (1.0f / 1024.0f) + 1e-6f);
                bf16_t* rowp = UP + (size_t)row * ldc + col0;
#pragma unroll
                for (int bj = 0; bj < 2; ++bj) { const f32x4 v0 = acc[ai][bj][m][0] * rs, v1 = acc[ai][bj][m][1] * rs;
                    u32x4 w; w.x = cvt_pk_bf16(v0[0], v0[1]); w.y = cvt_pk_bf16(v0[2], v0[3]); w.z = cvt_pk_bf16(v1[0], v1[1]); w.w = cvt_pk_bf16(v1[2], v1[3]);
                    *(u32x4*)(rowp + bj * HALF) = w; } }
    }
};
template <class Epi, class Sched, bool ALIGN_EPI = false, bool SP2 = false>
__device__ __forceinline__ void gemm_phase(PG8_LAS unsigned char* lds, const Gemm g, const Sched& S, const Epi& E) {
    const int tid = threadIdx.x, wid = __builtin_amdgcn_readfirstlane(tid >> 6), lane = tid & 63, wr = wid >> 2, wc = wid & 3, fr = lane & 15, fq = lane >> 4;
    const int K = g.K, nt = K / BK;
    unsigned voffA[2], voffB[2];
#pragma unroll
    for (int i = 0; i < 2; ++i) { int R, C; stage_rc(tid * 16 + i * 8192, R, C); const int Rb = Epi::PERM ? ((R & ~31) + perm32(R & 31)) : R;
        voffA[i] = (unsigned)(R * K + C) * 2u; voffB[i] = (unsigned)(Rb * K + C) * 2u; }
    const size_t kstep = (size_t)(BK * 2);
    const size_t hstep = (size_t)HALF * K * 2;
    const size_t tstep = 2 * hstep;
    const unsigned ldsw = (unsigned)wid * 1024u;
    const int aoff = lds_byte(wr * 64 + fr, fq * 8), boff = lds_byte(wc * 32 + fr, fq * 8);
#define PG8_SA(b, h) (((b) * 2 + (h)) * HTB)
#define PG8_SB(b, h) ((4 + (b) * 2 + (h)) * HTB)
#define PG8_STAGE(bufoff, gbase, voff) do { _Pragma("unroll") for (int _i = 0; _i < 2; ++_i) \
        __builtin_amdgcn_global_load_lds((const unsigned*)((const char*)(gbase) + (voff)[_i]), (PG8_LAS unsigned*)(lds + (bufoff) + ldsw + _i * 8192), 16, 0, 0); } while (0)
#define PG8_LDA(dst, b, h) do { _Pragma("unroll") for (int m = 0; m < 4; ++m) _Pragma("unroll") for (int k = 0; k < 2; ++k) dst[m][k] = *(const PG8_LAS bf16x8*)(lds + PG8_SA(b, h) + aoff + m * 2048 + k * 1024); } while (0)
#define PG8_LDB(dst, b, h) do { _Pragma("unroll") for (int n = 0; n < 2; ++n) _Pragma("unroll") for (int k = 0; k < 2; ++k) dst[n][k] = *(const PG8_LAS bf16x8*)(lds + PG8_SB(b, h) + boff + n * 2048 + k * 1024); } while (0)
#define PG8_MMA(ai, bj, At, Bt) do { __builtin_amdgcn_s_setprio(1); _Pragma("unroll") for (int m = 0; m < 4; ++m) _Pragma("unroll") for (int n = 0; n < 2; ++n) _Pragma("unroll") for (int k = 0; k < 2; ++k) \
        acc[ai][bj][m][n] = __builtin_amdgcn_mfma_f32_16x16x32_bf16(Bt[n][k], At[m][k], acc[ai][bj][m][n], 0, 0, 0); __builtin_amdgcn_s_setprio(0); } while (0)
#define PG8_WAIT_V(n) asm volatile("s_waitcnt vmcnt(" #n ")" ::: "memory")
#define PG8_WAIT_L(n) asm volatile("s_waitcnt lgkmcnt(" #n ")" ::: "memory")
#define PG8_BAR __builtin_amdgcn_s_barrier()
#define PG8_SCHED __builtin_amdgcn_sched_barrier(0)
    Unit cur, nxt; int ui = 0;
    if (!S.next(0, cur)) return;
    f32x4 acc[2][2][4][2];
#pragma unroll
    for (int a = 0; a < 2; ++a)
#pragma unroll
        for (int b = 0; b < 2; ++b)
#pragma unroll
            for (int m = 0; m < 4; ++m)
#pragma unroll
                for (int n = 0; n < 2; ++n) acc[a][b][m][n] = (f32x4){0.f, 0.f, 0.f, 0.f};
    bf16x8 At[4][2], B0[2][2], B1[2][2];
    const char* cA = (const char*)g.A + (size_t)cur.pm * tstep; const char* cB = (const char*)g.Bt + (size_t)cur.pn * tstep;
    S.a_ready(cur);
    if constexpr (SP2) {
        PG8_STAGE(PG8_SB(0, 0), cB, voffB); PG8_STAGE(PG8_SB(0, 1), cB + hstep, voffB); PG8_STAGE(PG8_SA(0, 0), cA, voffA); PG8_STAGE(PG8_SA(0, 1), cA + hstep, voffA);
        if (wr == 1) PG8_BAR;
        PG8_WAIT_V(2); PG8_BAR;
        PG8_STAGE(PG8_SB(1, 0), cB + kstep, voffB); PG8_STAGE(PG8_SA(1, 0), cA + kstep, voffA); PG8_STAGE(PG8_SB(1, 1), cB + hstep + kstep, voffB);
        PG8_WAIT_V(6); PG8_BAR;
    } else {
        PG8_STAGE(PG8_SB(0, 0), cB, voffB); PG8_STAGE(PG8_SA(0, 0), cA, voffA); PG8_STAGE(PG8_SB(0, 1), cB + hstep, voffB); PG8_STAGE(PG8_SA(0, 1), cA + hstep, voffA);
        if (wr == 1) PG8_BAR;
        PG8_WAIT_V(4); PG8_BAR;
        PG8_STAGE(PG8_SB(1, 0), cB + kstep, voffB); PG8_STAGE(PG8_SA(1, 0), cA + kstep, voffA); PG8_STAGE(PG8_SB(1, 1), cB + hstep + kstep, voffB);
        PG8_WAIT_V(6); PG8_BAR;
    }
    for (;;) {
        const bool has_next = S.next(ui + 1, nxt);
        const char* nA = has_next ? (const char*)g.A + (size_t)nxt.pm * tstep : cA; const char* nB = has_next ? (const char*)g.Bt + (size_t)nxt.pn * tstep : cB;
#pragma unroll 1
        for (int part = 0; part < (Epi::HAS_MID ? 2 : 1); ++part) {
        const int tb_ = (Epi::HAS_MID && part == 1) ? E.tmid : 0, te_ = (Epi::HAS_MID && part == 0) ? E.tmid : nt;
#pragma unroll 1
        for (int t = tb_; t < te_; t += 2) {
            const bool last = (t == nt - 2);
            const char* a1 = cA + (size_t)(t + 1) * kstep;
            const char* a2 = last ? nA : cA + (size_t)(t + 2) * kstep; const char* b2 = last ? nB : cB + (size_t)(t + 2) * kstep;
            const char* a3 = a2 + kstep; const char* b3 = b2 + kstep;
            if (last && has_next) S.a_ready(nxt);
            if constexpr (SP2) {
            PG8_LDB(B0, 0, 0); PG8_LDB(B1, 0, 1); PG8_SCHED; PG8_LDA(At, 0, 0); PG8_STAGE(PG8_SA(1, 1), a1 + hstep, voffA);
            PG8_WAIT_V(8); PG8_WAIT_L(0); PG8_BAR; PG8_MMA(0, 0, At, B0); PG8_MMA(0, 1, At, B1); PG8_BAR; PG8_SCHED;
            PG8_LDA(At, 0, 1); PG8_STAGE(PG8_SB(0, 0), b2, voffB); PG8_STAGE(PG8_SB(0, 1), b2 + hstep, voffB); PG8_STAGE(PG8_SA(0, 0), a2, voffA);
            PG8_WAIT_V(8); PG8_WAIT_L(0); PG8_BAR; PG8_MMA(1, 0, At, B0); PG8_MMA(1, 1, At, B1); PG8_BAR; PG8_SCHED;
            PG8_LDB(B0, 1, 0); PG8_LDB(B1, 1, 1); PG8_SCHED; PG8_LDA(At, 1, 0); PG8_STAGE(PG8_SA(0, 1), a2 + hstep, voffA);
            PG8_WAIT_V(8); PG8_WAIT_L(0); PG8_BAR; PG8_MMA(0, 0, At, B0); PG8_MMA(0, 1, At, B1); PG8_BAR; PG8_SCHED;
            PG8_LDA(At, 1, 1); PG8_STAGE(PG8_SB(1, 0), b3, voffB); PG8_STAGE(PG8_SB(1, 1), b3 + hstep, voffB); PG8_STAGE(PG8_SA(1, 0), a3, voffA);
            PG8_WAIT_V(8); PG8_WAIT_L(0); PG8_BAR; PG8_MMA(1, 0, At, B0); PG8_MMA(1, 1, At, B1); PG8_BAR; PG8_SCHED;
            } else {
            PG8_LDB(B0, 0, 0); PG8_SCHED; PG8_LDA(At, 0, 0); PG8_STAGE(PG8_SA(1, 1), a1 + hstep, voffA);
            PG8_WAIT_L(8); PG8_BAR; PG8_WAIT_L(0); PG8_MMA(0, 0, At, B0); PG8_BAR; PG8_SCHED;
            PG8_LDB(B1, 0, 1); PG8_STAGE(PG8_SB(0, 0), b2, voffB);
            PG8_BAR; PG8_WAIT_L(0); PG8_MMA(0, 1, At, B1); PG8_BAR;
            PG8_LDA(At, 0, 1); PG8_STAGE(PG8_SA(0, 0), a2, voffA);
            PG8_BAR; PG8_WAIT_L(0); PG8_MMA(1, 0, At, B0); PG8_BAR; PG8_SCHED;
            PG8_STAGE(PG8_SB(0, 1), b2 + hstep, voffB);
            PG8_WAIT_V(6); PG8_BAR; PG8_MMA(1, 1, At, B1); PG8_BAR;
            PG8_LDB(B0, 1, 0); PG8_SCHED; PG8_LDA(At, 1, 0); PG8_STAGE(PG8_SA(0, 1), a2 + hstep, voffA);
            PG8_WAIT_L(8); PG8_BAR; PG8_WAIT_L(0); PG8_MMA(0, 0, At, B0); PG8_BAR; PG8_SCHED;
            PG8_LDB(B1, 1, 1); PG8_STAGE(PG8_SB(1, 0), b3, voffB);
            PG8_BAR; PG8_WAIT_L(0); PG8_MMA(0, 1, At, B1); PG8_BAR;
            PG8_LDA(At, 1, 1); PG8_STAGE(PG8_SA(1, 0), a3, voffA);
            PG8_BAR; PG8_WAIT_L(0); PG8_MMA(1, 0, At, B0); PG8_BAR; PG8_SCHED;
            PG8_STAGE(PG8_SB(1, 1), b3 + hstep, voffB);
            PG8_WAIT_V(6); PG8_BAR; PG8_MMA(1, 1, At, B1); PG8_BAR;
            }
        }
        if constexpr (Epi::HAS_MID) { if (part == 0) E.mid(acc, cur, wr, wc, fr, fq); }
        }
        if constexpr (ALIGN_EPI) { if (wr == 0) PG8_BAR; }
        if constexpr (!Epi::AFTER_DRAIN) { E(acc, cur, wr, wc, fr, fq); S.done(cur); }
        if (!has_next) break;
#pragma unroll
        for (int a = 0; a < 2; ++a)
#pragma unroll
            for (int b = 0; b < 2; ++b)
#pragma unroll
                for (int m = 0; m < 4; ++m)
#pragma unroll
                    for (int n = 0; n < 2; ++n) acc[a][b][m][n] = (f32x4){0.f, 0.f, 0.f, 0.f};
        cur = nxt; cA = nA; cB = nB; ++ui;
        if constexpr (ALIGN_EPI) { if (wr == 1) PG8_BAR; }
    }
    PG8_WAIT_V(0);
    if constexpr (!ALIGN_EPI) { if (wr == 0) PG8_BAR; }
    PG8_BAR;
    if constexpr (Epi::AFTER_DRAIN) { E.fused(acc, cur, wr, wc, fr, fq, lds, wid, lane); S.done(cur); }
#undef PG8_SA
#undef PG8_SB
#undef PG8_STAGE
#undef PG8_LDA
#undef PG8_LDB
#undef PG8_MMA
#undef PG8_WAIT_V
#undef PG8_WAIT_L
#undef PG8_BAR
#undef PG8_SCHED
}
}
#ifndef PG8_SP2
#define PG8_SP2 true
#endif
#ifndef PG8_ALIGN
#define PG8_ALIGN true
#endif
constexpr int NWAVES = 8;
constexpr int N_LAUNCHES = MK_N_LAUNCHES;
constexpr int N_PHASES = 13;
constexpr int NB = 4, S = 8192, D = 1024, M = NB * S;
constexpr int LW = 1280, NH = 10, HD = 128, PW = 1024, INW = 4352, FF = 2816, FF2 = 5632, KM = LW + PW  ;
constexpr float EPS = 1e-6f;
constexpr int SEG = 16, NSEG = S / SEG;
constexpr int TC = 256, NCHUNK = S / TC;
constexpr size_t MiB = 1u << 20;
constexpr size_t WS_CTL = 0, CTL_ZERO_BYTES = 64 * 1024;
constexpr size_t OFF_WIN = 1 * MiB;
constexpr size_t OFF_WUP = 10 * MiB;
constexpr size_t OFF_WD = 21 * MiB;
constexpr size_t OFF_BT2 = 27 * MiB;
constexpr size_t OFF_WO = 32 * MiB;
constexpr size_t OFF_WG = 34 * MiB;
constexpr size_t OFF_RS1 = 36 * MiB;
constexpr size_t OFF_BC = OFF_RS1 + 128 * 1024;
constexpr size_t OFF_LAMC = OFF_BC + 4096;
constexpr size_t OFF_PS2 = 38 * MiB;
constexpr size_t OFF_PS3 = 40 * MiB;
constexpr size_t OFF_UA = 48 * MiB;
constexpr size_t OFF_X1B = 48 * MiB;
constexpr size_t OFF_UB = 128 * MiB;
constexpr size_t OFF_MG = 128 * MiB;
constexpr size_t OFF_RAT = 192 * MiB;
constexpr size_t OFF_GB = 256 * MiB;
constexpr size_t OFF_HP = 320 * MiB;
constexpr size_t OFF_XB = 448 * MiB;
constexpr size_t OFF_UP = 112 * MiB;
constexpr size_t OFF_ACT = 288 * MiB;
constexpr size_t WS_NEED = 512 * MiB;
constexpr size_t DO_CAR = 0, DO_HIN = 40 * MiB;
constexpr int CW_TMO = 0, CW_BAR = 4096;
constexpr int RING_OFF = 0, RING_BYTES = 131072;
constexpr int LDSCTL_OFF = RING_BYTES, MISC_OFF = LDSCTL_OFF + 320;
constexpr int LDS_BYTES = 147456;
enum { I_X = 0, I_GMIX, I_WIN, I_BGATE, I_CAW, I_CAB, I_WAF, I_BAF, I_WXF, I_BXF, I_LAMF, I_WAB, I_BAB, I_WXB, I_BXB, I_LAMB,
       I_WPOOL, I_BPOOL, I_PSCALE, I_PA, I_PB, I_WOUT, I_GFFN, I_WUP, I_CFW, I_CFB, I_WDOWN, I_GFINAL, N_IN };

#define GAS __attribute__((address_space(1)))
#define LAS __attribute__((address_space(3)))
typedef unsigned short bf16;
typedef unsigned v4u __attribute__((ext_vector_type(4)));
typedef float f32x4 __attribute__((ext_vector_type(4)));
typedef float f32x2 __attribute__((ext_vector_type(2)));
typedef float f32x16 __attribute__((ext_vector_type(16)));
typedef short bf16x8 __attribute__((ext_vector_type(8)));
typedef GAS unsigned gu32;
#define RLX_AGENT __ATOMIC_RELAXED, __HIP_MEMORY_SCOPE_AGENT
#define LDS_WAIT() asm volatile("s_waitcnt lgkmcnt(0)" ::: "memory")
#define VM_WAIT() asm volatile("s_waitcnt vmcnt(0)" ::: "memory")
__device__ __forceinline__ unsigned f2bf(float f) { unsigned u = __builtin_bit_cast(unsigned, f); return (u + 0x7fffu + ((u >> 16) & 1u)) >> 16; }
__device__ __forceinline__ unsigned pk2(float lo, float hi) { return f2bf(lo) | (f2bf(hi) << 16); }
__device__ __forceinline__ float bflo(unsigned w) { return __uint_as_float(w << 16); }
__device__ __forceinline__ float bfhi(unsigned w) { return __uint_as_float(w & 0xffff0000u); }
constexpr float LOG2E = 1.4426950408889634f;
#define XB_TMO      128
#define XB_XCNT(j)  (256  + 64 * (j))
#define XB_XSUB(j)  (1280 + 64 * (j))
#define XB_XGEN(j)  (2304 + 64 * (j))
#define XB_TOP      3328
#define XB_TOPGEN   3392
#define XCD_BAR_WORDS 3456
#define XB_SPIN_CAP (1u << 18)

__device__ __forceinline__ unsigned xb_ld(unsigned* p)              { return __hip_atomic_load(p, __ATOMIC_RELAXED, __HIP_MEMORY_SCOPE_AGENT); }
__device__ __forceinline__ unsigned xb_add(unsigned* p, unsigned v) { return __hip_atomic_fetch_add(p, v, __ATOMIC_RELAXED, __HIP_MEMORY_SCOPE_AGENT); }
__device__ __forceinline__ unsigned xb_xcc_id() { return (unsigned)__builtin_amdgcn_s_getreg((3 << 11) | 20) & 0xFu; }
#define XB_SPIN(cond, bar) do { unsigned _sp = 0; while (cond) { __builtin_amdgcn_s_sleep(1); \
    if ((++_sp & 255u) == 0u) { if (xb_ld(&(bar)[XB_TMO])) break; if (_sp > XB_SPIN_CAP) { atomicAdd(&(bar)[XB_TMO], 1u); break; } } } } while (0)

struct XcdBarrier {
    unsigned* bar; unsigned x;
    volatile LAS unsigned* st;
};

__device__ __forceinline__ XcdBarrier xcd_barrier_post(unsigned* bar, volatile LAS unsigned* st) {
    XcdBarrier b; b.bar = bar; b.x = xb_xcc_id(); b.st = st;
    if (threadIdx.x == 0) (void)xb_add(&bar[XB_XCNT(b.x)], 1u);
    return b;
}
__device__ __forceinline__ void xcd_barrier_complete(unsigned* bar, unsigned x, unsigned& nloc, unsigned& nx) {
    const unsigned G = gridDim.x * gridDim.y * gridDim.z;
    unsigned sum, cnt, mine, sp = 0u;
    for (;;) {
        sum = 0u; cnt = 0u; mine = 0u;
#pragma unroll
        for (unsigned j = 0; j < 16; ++j) { const unsigned c = xb_ld(&bar[XB_XCNT(j)]); sum += c; cnt += (c > 0u) ? 1u : 0u; mine = (j == x) ? c : mine; }
        if (sum == G) break;
        __builtin_amdgcn_s_sleep(1);
        if ((++sp & 255u) == 0u) { if (xb_ld(&bar[XB_TMO])) break; if (sp > XB_SPIN_CAP) { atomicAdd(&bar[XB_TMO], 1u); break; } }
    }
    nloc = mine > 0u ? mine : 1u; nx = cnt > 0u ? cnt : 1u;
}

__device__ __forceinline__ void xcd_barrier(const XcdBarrier& b) {
    asm volatile("s_waitcnt vmcnt(0)" ::: "memory");
    __syncthreads();
    if (threadIdx.x == 0) {
        unsigned* bar = b.bar;
        __builtin_amdgcn_s_waitcnt(0);
        unsigned nloc = b.st[0], nx = b.st[1];
        if (nloc == 0u) { xcd_barrier_complete(bar, b.x, nloc, nx); b.st[0] = nloc; b.st[1] = nx; }
        const unsigned old = xb_add(&bar[XB_XSUB(b.x)], 1u);
        const unsigned gen = old / nloc;
        if (old + 1u == (gen + 1u) * nloc) {
            __builtin_amdgcn_fence(__ATOMIC_RELEASE, "agent");
            asm volatile("s_waitcnt vmcnt(0)" ::: "memory");
            const unsigned og = xb_add(&bar[XB_TOP], 1u);
            const unsigned tg = og / nx;
            if (og + 1u == (tg + 1u) * nx) xb_add(&bar[XB_TOPGEN], 1u);
            else XB_SPIN(xb_ld(&bar[XB_TOPGEN]) == tg, bar);
            __builtin_amdgcn_fence(__ATOMIC_ACQUIRE, "agent");
            xb_add(&bar[XB_XGEN(b.x)], 1u);
            asm volatile("s_waitcnt vmcnt(0)" ::: "memory");
        } else {
            XB_SPIN(xb_ld(&bar[XB_XGEN(b.x)]) == gen, bar);
            __builtin_amdgcn_fence(__ATOMIC_ACQUIRE, "agent");
            asm volatile("s_waitcnt vmcnt(0)" ::: "memory");
        }
    }
    __syncthreads();
}
struct Frame {
    LAS unsigned char* lds;
    volatile LAS unsigned* MISC;
    gu32* ctl;
    int tid, lane, wave;
    int vcu, G;
    const float* in[N_IN];
    float* out; unsigned char* ws;
};
__device__ __forceinline__ float wave_sum(float v) {
#pragma unroll
    for (int o = 1; o < 64; o <<= 1) v += __shfl_xor(v, o);
    return v;
}

__device__ __forceinline__ void p0_transpose_item(const float* W, int N, const float* kscale, bf16* dst_row0  , int ldk, int k0, int n0, int swz, LAS float* scr, int lane) {
#pragma unroll 8
    for (int i = 0; i < 32; ++i) { const int kk = 2 * i + (lane >> 5); float v = W[(size_t)(k0 + kk) * N + n0 + (lane & 31)]; if (kscale) v *= kscale[k0 + kk]; scr[kk * 33 + (lane & 31)] = v; }
    LDS_WAIT(); asm volatile("" ::: "memory");
    const int c = lane & 7;
#pragma unroll
    for (int j = 0; j < 4; ++j) { const int n = (lane >> 3) + 8 * j; const LAS float* s = scr + (8 * c) * 33 + n;
        v4u o; o.x = pk2(s[0 * 33], s[1 * 33]); o.y = pk2(s[2 * 33], s[3 * 33]); o.z = pk2(s[4 * 33], s[5 * 33]); o.w = pk2(s[6 * 33], s[7 * 33]);
        int chunk = (k0 >> 3) + c; if (swz) chunk ^= (n0 + n) & 15;
        *(GAS v4u*)(dst_row0 + (size_t)n * ldk + chunk * 8) = o; }
    LDS_WAIT(); asm volatile("" ::: "memory");
}
__device__ __forceinline__ void p0_prologue(Frame& F) {
    LAS float* scr = (LAS float*)(F.lds + RING_OFF + F.wave * 16384);
    const int gw = F.vcu * NWAVES + F.wave, NGW = F.G * NWAVES;
    bf16* WinT = (bf16*)(F.ws + OFF_WIN); bf16* WupT = (bf16*)(F.ws + OFF_WUP); bf16* WdT = (bf16*)(F.ws + OFF_WD); bf16* BT2 = (bf16*)(F.ws + OFF_BT2);
    bf16* WoT = (bf16*)(F.ws + OFF_WO); bf16* WgT = (bf16*)(F.ws + OFF_WG);
    constexpr int I_IN = (D / 64) * (INW / 32), I_UP = (D / 64) * (FF2 / 32), I_DN = (FF / 64) * (D / 32), I_PAI = (LW / 64) * (D / 32), I_WOI = (D / 64) * (D / 32), I_G = NH * 4 * 2 * 4;
    constexpr int NITEMS = I_IN + I_UP + I_DN + I_PAI + I_WOI + I_G;
    for (int it = gw; it < NITEMS; it += NGW) {
        int r = it;
        if (r < I_IN) { const int nblk = INW / 32, kb = r / nblk, n0 = (r % nblk) * 32; int drow = n0;
            if (n0 >= LW + PW) { const int c2 = n0 - (LW + PW), bj = c2 >> 10, ch = c2 & 1023; drow = LW + PW + 256 * (ch >> 7) + 128 * bj + (ch & 127); }
            p0_transpose_item(F.in[I_WIN], INW, F.in[I_GMIX], WinT + (size_t)drow * D, D, 64 * kb, n0, 0, scr, F.lane); continue; } r -= I_IN;
        if (r < I_UP) { const int nblk = FF2 / 32, kb = r / nblk, n0 = (r % nblk) * 32; const int bj = n0 / FF, ch = n0 % FF; const int drow = 256 * (ch >> 7) + 128 * bj + (ch & 127);
            p0_transpose_item(F.in[I_WUP], FF2, F.in[I_GFFN], WupT + (size_t)drow * D, D, 64 * kb, n0, 0, scr, F.lane); continue; } r -= I_UP;
        if (r < I_DN) { const int nblk = D / 32, kb = r / nblk, n0 = (r % nblk) * 32;
            p0_transpose_item(F.in[I_WDOWN], D, nullptr, WdT + (size_t)n0 * FF, FF, 64 * kb, n0, 0, scr, F.lane); continue; } r -= I_DN;
        if (r < I_PAI) { const int nblk = D / 32, kb = r / nblk, n0 = (r % nblk) * 32;
            p0_transpose_item(F.in[I_PA], D, nullptr, BT2 + (size_t)n0 * KM, KM, 64 * kb, n0, 0, scr, F.lane); continue; } r -= I_PAI;
        if (r < I_WOI) { const int nblk = D / 32, kb = r / nblk, n0 = (r % nblk) * 32;
            p0_transpose_item(F.in[I_WOUT], D, nullptr, WoT + (size_t)n0 * D, D, 64 * kb, n0, 0, scr, F.lane); continue; } r -= I_WOI;
        {
            const int hd = r / 32, g = (r >> 3) & 3, kb = (r >> 2) & 1, n0 = (r & 3) * 32;
            const float* src = (g == 0 ? F.in[I_WAF] : g == 1 ? F.in[I_WXF] : g == 2 ? F.in[I_WAB] : F.in[I_WXB]) + (size_t)hd * HD * HD;
            p0_transpose_item(src, HD, nullptr, WgT + ((size_t)hd * 512 + g * 128 + n0) * HD, HD, 64 * kb, n0, 1, scr, F.lane); }
    }
    const int gt = F.vcu * (NWAVES * 64) + F.tid, NGT = F.G * NWAVES * 64;
    for (int i = gt; i < D * PW; i += NGT) { const int n = i >> 10, k = i & 1023, g = k >> 8, kk = k & 255;
        const float* wp = F.in[I_WPOOL] + (size_t)g * 65536 + kk * 256; const float* sc = F.in[I_PSCALE] + g * 256; const float* pb = F.in[I_PB] + (size_t)(g * 256) * D + n;
        float s = 0.f;
#pragma unroll 8
        for (int j = 0; j < 256; ++j) s += wp[j] * sc[j] * pb[(size_t)j * D];
        BT2[(size_t)n * KM + LW + k] = (bf16)f2bf(s); }
    if (gt < D) { float s = 0.f;
#pragma unroll 8
        for (int c = 0; c < PW; ++c) s += F.in[I_BPOOL][c] * F.in[I_PSCALE][c] * F.in[I_PB][(size_t)c * D + gt];
        ((float*)(F.ws + OFF_BC))[gt] = s; }
    if (gt >= D && gt < D + 2 * LW) { const int i = gt - D; const float lam = (i < LW ? F.in[I_LAMF] : F.in[I_LAMB])[i % LW]; ((float*)(F.ws + OFF_LAMC))[i] = -8.0f * LOG2E * log1pf(expf(-lam)); }
    float* rs1 = (float*)(F.ws + OFF_RS1); bf16* XB = (bf16*)(F.ws + OFF_XB);
    for (int m = gw; m < M; m += NGW) {
        const GAS f32x4* xr = (const GAS f32x4*)(F.in[I_X] + (size_t)m * D) + F.lane;
        f32x4 v[4]; float s = 0.f;
#pragma unroll
        for (int j = 0; j < 4; ++j) { v[j] = xr[64 * j]; s += (v[j].x * v[j].x + v[j].y * v[j].y) + (v[j].z * v[j].z + v[j].w * v[j].w); }
        s = wave_sum(s);
        if (F.lane == 0) rs1[m] = 1.0f / sqrtf(s * (1.0f / D) + EPS);
        GAS unsigned long long* o8 = (GAS unsigned long long*)(XB + (size_t)m * D) + F.lane;
#pragma unroll
        for (int j = 0; j < 4; ++j) o8[64 * j] = (unsigned long long)pk2(v[j].x, v[j].y) | ((unsigned long long)pk2(v[j].z, v[j].w) << 32);
    }
}

template <bool FINAL>
__device__ __forceinline__ void scan_phase(Frame& F) {
    const int tid = F.tid, lane = F.lane, w = F.wave, c31 = lane & 31, hi = lane >> 5;
    LAS unsigned char* xat = F.lds + RING_OFF;
    LAS unsigned char* bbuf = F.lds + RING_OFF + 65536;
    const bf16* UA = (const bf16*)(F.ws + OFF_UA); const unsigned char* WgT = F.ws + OFF_WG; const float* lamc = (const float*)(F.ws + OFF_LAMC);
    f32x2* CAR = (f32x2*)((unsigned char*)F.out + DO_CAR); const float* HIN = (const float*)((unsigned char*)F.out + DO_HIN); bf16* HP = (bf16*)(F.ws + OFF_HP);
    const int NITEM = NB * NCHUNK * NH;
    const int tau = (c31 & 3) + 4 * (c31 >> 3) + 16 * ((c31 >> 2) & 1);
    const int arow = 32 * w + tau;
    const unsigned ldsw = (unsigned)w * 1024u;
#define SC_BGLDS(hd_, q_, buf_) do { _Pragma("unroll") for (int i_ = 0; i_ < 4; ++i_) { const int p_ = tid + 512 * i_, nl_ = p_ >> 4, ch_ = p_ & 15; const int ng_ = (nl_ >> 5) * 128 + 32 * (q_) + (nl_ & 31); \
        __builtin_amdgcn_global_load_lds((const unsigned*)(WgT + ((size_t)(hd_) * 512 + ng_) * 256 + ch_ * 16), (LAS unsigned*)(bbuf + (buf_) * 32768 + i_ * 8192 + ldsw), 16, 0, 0); } } while (0)
    int cur = 0; bool first = true;
    for (int it = F.vcu; it < NITEM; it += F.G) {
        const int hd = it % NH, bc_ = it / NH, b = bc_ / NCHUNK, t0 = (bc_ % NCHUNK) * TC;
        if (first) { SC_BGLDS(hd, 0, 0); cur = 0; first = false; }
        {
            const int cc = tid & 15, tg = tid >> 4;
            const int chg = hd * HD + 8 * cc;
            f32x4 wv[4][2], cb[2];
#pragma unroll
            for (int k = 0; k < 4; ++k) { wv[k][0] = *(const GAS f32x4*)(F.in[I_CAW] + k * LW + chg); wv[k][1] = *(const GAS f32x4*)(F.in[I_CAW] + k * LW + chg + 4); }
            cb[0] = *(const GAS f32x4*)(F.in[I_CAB] + chg); cb[1] = *(const GAS f32x4*)(F.in[I_CAB] + chg + 4);
            v4u u[11];
#pragma unroll
            for (int i = 0; i < 11; ++i) { const int t = t0 + 8 * tg - 2 + i; u[i] = (v4u){0u, 0u, 0u, 0u};
                if (t >= 0 && t < S) u[i] = *(const GAS v4u*)(UA + ((size_t)b * S + t) * LW + chg); }
#pragma unroll
            for (int tt = 0; tt < 8; ++tt) { f32x4 a0 = cb[0], a1 = cb[1];
#pragma unroll
                for (int k = 0; k < 4; ++k) { const v4u x = u[tt + k];
                    a0 += wv[k][0] * (f32x4){bflo(x.x), bfhi(x.x), bflo(x.y), bfhi(x.y)}; a1 += wv[k][1] * (f32x4){bflo(x.z), bfhi(x.z), bflo(x.w), bfhi(x.w)}; }
                const int row = 8 * tg + tt; v4u o; o.x = pk2(a0[0], a0[1]); o.y = pk2(a0[2], a0[3]); o.z = pk2(a1[0], a1[1]); o.w = pk2(a1[2], a1[3]);
                *(LAS v4u*)(xat + row * 256 + ((cc ^ (row & 15)) << 4)) = o; }
        }
        VM_WAIT(); LDS_WAIT(); __builtin_amdgcn_s_barrier(); asm volatile("" ::: "memory");
        bf16x8 af[8];
#pragma unroll
        for (int ks = 0; ks < 8; ++ks) af[ks] = *(const LAS bf16x8*)(xat + arow * 256 + (((2 * ks + hi) ^ (arow & 15)) << 4));
#pragma unroll 1
        for (int q = 0; q < 4; ++q) {
            { const int itn = it + F.G; if (q < 3) SC_BGLDS(hd, q + 1, cur ^ 1); else if (itn < NITEM) SC_BGLDS(itn % NH, 0, cur ^ 1); }
            const int cl = 32 * q + c31, cg = hd * HD + cl, seg = (t0 + 32 * w + 16 * hi) / SEG;
            float xa[16];
#pragma unroll
            for (int r = 0; r < 16; ++r) { const int row = 32 * w + 16 * hi + r; xa[r] = __uint_as_float((unsigned)(*(const LAS unsigned short*)(xat + row * 256 + (((cl >> 3) ^ r) << 4) + (cl & 7) * 2)) << 16); }
            float hsum[16];
#pragma unroll
            for (int dir = 0; dir < 2; ++dir) {
                f32x16 ga, gx;
#pragma unroll
                for (int r = 0; r < 16; ++r) { ga[r] = 0.f; gx[r] = 0.f; }
#pragma unroll
                for (int ks = 0; ks < 8; ++ks) { const int na = 32 * (2 * dir) + c31, nx = na + 32;
                    const bf16x8 ba_ = *(const LAS bf16x8*)(bbuf + cur * 32768 + na * 256 + (((2 * ks + hi) ^ (na & 15)) << 4));
                    const bf16x8 bx_ = *(const LAS bf16x8*)(bbuf + cur * 32768 + nx * 256 + (((2 * ks + hi) ^ (nx & 15)) << 4));
                    ga = __builtin_amdgcn_mfma_f32_32x32x16_bf16(af[ks], ba_, ga, 0, 0, 0); gx = __builtin_amdgcn_mfma_f32_32x32x16_bf16(af[ks], bx_, gx, 0, 0, 0); }
                const float nba = -LOG2E * (dir ? F.in[I_BAB] : F.in[I_BAF])[cg], nbx = -LOG2E * (dir ? F.in[I_BXB] : F.in[I_BXF])[cg], lc2 = lamc[dir * LW + cg];
                float av[16], bv[16];
#pragma unroll
                for (int r = 0; r < 16; ++r) {
                    const float er = __builtin_amdgcn_exp2f(ga[r] * (-LOG2E) + nba), rg = __builtin_amdgcn_rcpf(1.0f + er);
                    const float a = __builtin_amdgcn_exp2f(lc2 * rg);
                    const float ei = __builtin_amdgcn_exp2f(gx[r] * (-LOG2E) + nbx), ig = __builtin_amdgcn_rcpf(1.0f + ei);
                    av[r] = a; bv[r] = __builtin_amdgcn_sqrtf(fmaxf(1.0f - a * a, 0.f)) * (ig * xa[r]); }
                if (!FINAL) {
                    float A = 1.f, Bv = 0.f;
#pragma unroll
                    for (int i = 0; i < 16; ++i) { const int r = dir ? 15 - i : i; Bv = av[r] * Bv + bv[r]; A *= av[r]; }
                    CAR[(((size_t)dir * NB + b) * NSEG + seg) * LW + cg] = (f32x2){A, Bv};
                } else {
                    float h = HIN[(((size_t)dir * NB + b) * NSEG + seg) * LW + cg];
#pragma unroll
                    for (int i = 0; i < 16; ++i) { const int r = dir ? 15 - i : i; h = av[r] * h + bv[r]; if (dir == 0) hsum[r] = h; else hsum[r] += h; }
                }
            }
            if (FINAL) {
#pragma unroll
                for (int r = 0; r < 16; ++r) { const int row = 32 * w + 16 * hi + r; *(LAS unsigned short*)(xat + row * 256 + (((cl >> 3) ^ r) << 4) + (cl & 7) * 2) = (unsigned short)f2bf(hsum[r]); }
            }
            VM_WAIT(); LDS_WAIT(); __builtin_amdgcn_s_barrier(); asm volatile("" ::: "memory");
            cur ^= 1;
        }
        if (FINAL) {
#pragma unroll
            for (int i = 0; i < 8; ++i) { const int p = tid + 512 * i, row = p >> 4, chs = p & 15; const v4u v = *(const LAS v4u*)(xat + row * 256 + (chs << 4));
                *(GAS v4u*)(HP + ((size_t)b * S + t0 + row) * KM + hd * HD + ((chs ^ (row & 15)) << 3)) = v; }
            LDS_WAIT(); __builtin_amdgcn_s_barrier(); asm volatile("" ::: "memory");
        }
    }
#undef SC_BGLDS
}

__device__ __forceinline__ void carry_pool_phase(Frame& F) {
    {
        const f32x2* CAR = (const f32x2*)((unsigned char*)F.out + DO_CAR); float* HIN = (float*)((unsigned char*)F.out + DO_HIN);
        LAS f32x2* sh = (LAS f32x2*)(F.lds + RING_OFF);
        for (int task = F.vcu; task < 2 * NB * (LW / 64); task += F.G) {
            const int cgp = task % (LW / 64), db = task / (LW / 64), dir = db / NB, ss = F.tid >> 6, c = cgp * 64 + F.lane;
            const size_t base = (size_t)db * NSEG * LW + c;
            const long sstep = dir ? -(long)LW : (long)LW; const f32x2* cp = CAR + base + (size_t)(dir ? (NSEG - 1 - ss * 64) : ss * 64) * LW;
            float A = 1.f, Bv = 0.f;
#pragma unroll 16
            for (int i = 0; i < 64; ++i) { const f32x2 ab = cp[(long)i * sstep]; Bv = ab.x * Bv + ab.y; A *= ab.x; }
            sh[ss * 64 + F.lane] = (f32x2){A, Bv};
            LDS_WAIT(); __builtin_amdgcn_s_barrier(); asm volatile("" ::: "memory");
            float h = 0.f;
            for (int s2 = 0; s2 < ss; ++s2) { const f32x2 t = sh[s2 * 64 + F.lane]; h = t.x * h + t.y; }
            float* hp = HIN + base + (size_t)(dir ? (NSEG - 1 - ss * 64) : ss * 64) * LW;
#pragma unroll 16
            for (int i = 0; i < 64; ++i) { const f32x2 ab = cp[(long)i * sstep]; hp[(long)i * sstep] = h; h = ab.x * h + ab.y; }
            LDS_WAIT(); __builtin_amdgcn_s_barrier(); asm volatile("" ::: "memory");
        }
    }
    {
        const bf16* UB = (const bf16*)(F.ws + OFF_UB); bf16* HP = (bf16*)(F.ws + OFF_HP);
        const int gt = F.vcu * (NWAVES * 64) + F.tid, NGT = F.G * NWAVES * 64;
        for (int item = gt; item < (M / 32) * (PW / 8); item += NGT) {
            const int cc = item & 127, tb = item >> 7, b = tb / (S / 32), t0 = (tb % (S / 32)) * 32, g = cc >> 5, hw = 1 << g;
            const bf16* ub = UB + (size_t)b * S * PW + cc * 8;
            float sum[8];
#pragma unroll
            for (int j = 0; j < 8; ++j) sum[j] = 0.f;
#define PL_ADD(t_, sgn_) do { const int tq_ = (t_); if (tq_ >= 0 && tq_ < S) { const v4u x_ = *(const GAS v4u*)(ub + (size_t)tq_ * PW); \
                sum[0] += (sgn_) * bflo(x_.x); sum[1] += (sgn_) * bfhi(x_.x); sum[2] += (sgn_) * bflo(x_.y); sum[3] += (sgn_) * bfhi(x_.y); sum[4] += (sgn_) * bflo(x_.z); sum[5] += (sgn_) * bfhi(x_.z); sum[6] += (sgn_) * bflo(x_.w); sum[7] += (sgn_) * bfhi(x_.w); } } while (0)
            for (int t = t0 - hw; t <= t0 + hw - 1; ++t) PL_ADD(t, 1.f);
            for (int i = 0; i < 32; ++i) { const int t = t0 + i;
                const int lo = max(t - hw, 0), hi = min(t + hw - 1, S - 1); const float inv = 1.0f / (float)(hi - lo + 1);
                const v4u x = *(const GAS v4u*)(ub + (size_t)t * PW);
                v4u o; o.x = pk2(sum[0] * inv - bflo(x.x), sum[1] * inv - bfhi(x.x)); o.y = pk2(sum[2] * inv - bflo(x.y), sum[3] * inv - bfhi(x.y));
                o.z = pk2(sum[4] * inv - bflo(x.z), sum[5] * inv - bfhi(x.z)); o.w = pk2(sum[6] * inv - bflo(x.w), sum[7] * inv - bfhi(x.w));
                *(GAS v4u*)(HP + ((size_t)b * S + t) * KM + LW + cc * 8) = o;
                PL_ADD(t + hw, 1.f); PL_ADD(t - hw, -1.f); }
        }
    }
}

__device__ __forceinline__ void act_phase(Frame& F, int rowbase) {
    const bf16* UP = (const bf16*)(F.ws + OFF_UP); bf16* ACT = (bf16*)(F.ws + OFF_ACT);
    const int gt = F.vcu * (NWAVES * 64) + F.tid, NGT = F.G * NWAVES * 64;
    for (int item = gt; item < (M / 2) * (FF / 8); item += NGT) {
        const int lr = item / (FF / 8), cc = item % (FF / 8), ch = cc * 8, t = (rowbase + lr) % S;
        const int gcol = (ch >> 7) * 256 + (ch & 127);
        f32x4 g0 = *(const GAS f32x4*)(F.in[I_CFB] + ch), g1 = *(const GAS f32x4*)(F.in[I_CFB] + ch + 4), v0 = *(const GAS f32x4*)(F.in[I_CFB] + FF + ch), v1 = *(const GAS f32x4*)(F.in[I_CFB] + FF + ch + 4);
#pragma unroll
        for (int k = 0; k < 3; ++k) { const int tt = t + k - 1; if (tt >= 0 && tt < S) { const bf16* r = UP + (size_t)(lr + k - 1) * FF2 + gcol;
            const v4u xg = *(const GAS v4u*)r, xv = *(const GAS v4u*)(r + 128);
            const float* wg = F.in[I_CFW] + k * FF2 + ch; const float* wv = wg + FF;
            g0 += *(const GAS f32x4*)wg * (f32x4){bflo(xg.x), bfhi(xg.x), bflo(xg.y), bfhi(xg.y)}; g1 += *(const GAS f32x4*)(wg + 4) * (f32x4){bflo(xg.z), bfhi(xg.z), bflo(xg.w), bfhi(xg.w)};
            v0 += *(const GAS f32x4*)wv * (f32x4){bflo(xv.x), bfhi(xv.x), bflo(xv.y), bfhi(xv.y)}; v1 += *(const GAS f32x4*)(wv + 4) * (f32x4){bflo(xv.z), bfhi(xv.z), bflo(xv.w), bfhi(xv.w)}; } }
        float o[8];
#pragma unroll
        for (int j = 0; j < 8; ++j) { const float g = j < 4 ? g0[j] : g1[j - 4], v = j < 4 ? v0[j] : v1[j - 4];
            const float u2 = g * (1.5957691216057308f + 0.07135481627f * g * g);
            o[j] = g * __builtin_amdgcn_rcpf(1.0f + __builtin_amdgcn_exp2f(-LOG2E * u2)) * v; }
        v4u w; w.x = pk2(o[0], o[1]); w.y = pk2(o[2], o[3]); w.z = pk2(o[4], o[5]); w.w = pk2(o[6], o[7]);
        *(GAS v4u*)(ACT + (size_t)(rowbase + lr) * FF + ch) = w;
    }
}

__device__ __forceinline__ void final_phase(Frame& F) {
    const int gw = F.vcu * NWAVES + F.wave, NGW = F.G * NWAVES; const float* PS = (const float*)(F.ws + OFF_PS3);
    for (int m = gw; m < M; m += NGW) {
        const f32x4* ps = (const f32x4*)(PS + (size_t)m * 16); const f32x4 s4 = (ps[0] + ps[1]) + (ps[2] + ps[3]);
        const float rs = 1.0f / sqrtf(((s4[0] + s4[1]) + (s4[2] + s4[3])) * (1.0f / D) + EPS);
        GAS f32x4* xr = (GAS f32x4*)(F.out + (size_t)m * D) + F.lane; const GAS f32x4* gr = (const GAS f32x4*)F.in[I_GFINAL] + F.lane;
#pragma unroll
        for (int j = 0; j < 4; ++j) xr[64 * j] = xr[64 * j] * rs * gr[64 * j];
    }
}

struct Args { const float* in[N_IN]; float* out; unsigned char* ws; int ph_lo, ph_hi, li, pad; };
__global__ void __launch_bounds__(NWAVES * 64, 2) mk_fwd(Args args) {
    extern __shared__ __attribute__((aligned(16))) unsigned char lds[];
    Frame F;
    F.lds = (LAS unsigned char*)lds;
    F.MISC = (volatile LAS unsigned*)(F.lds + MISC_OFF);
    F.tid = threadIdx.x; F.lane = F.tid & 63; F.wave = __builtin_amdgcn_readfirstlane(F.tid >> 6);
    F.G = gridDim.x; { const int bx = blockIdx.x; F.vcu = (F.G % 8 == 0) ? (bx % 8) * (F.G / 8) + bx / 8 : bx; }
#pragma unroll
    for (int i = 0; i < N_IN; ++i) F.in[i] = args.in[i];
    F.out = args.out; F.ws = args.ws;
    F.ctl = (gu32*)(args.ws + WS_CTL);
    for (int u = F.tid; u < (LDS_BYTES - LDSCTL_OFF) / 4; u += NWAVES * 64) ((LAS unsigned*)(F.lds + LDSCTL_OFF))[u] = 0u;
    __syncthreads();
    XcdBarrier bar; bar.bar = (unsigned*)(F.ctl + CW_BAR); bar.x = 0; bar.st = nullptr;
    if (N_LAUNCHES == 1) bar = xcd_barrier_post((unsigned*)(F.ctl + CW_BAR), F.MISC + 8);
    const int lo = args.ph_lo, hi = args.ph_hi;
#define IN(k) (lo <= (k) && (k) < hi)
#define SEAM(k) do { if (IN(k) && IN((k) + 1)) xcd_barrier(bar); } while (0)
    unsigned char* ws = args.ws;
#ifndef SKIP0
    if (IN(0)) { p0_prologue(F); VM_WAIT(); __syncthreads(); }
#endif
    SEAM(0);
    if (IN(1)) {
        pg8::Gemm g{(const bf16*)(ws + OFF_XB), (const bf16*)(ws + OFF_WIN), M, INW, D}; pg8::StaticOrder So; So.init(M, INW, F.G, (int)blockIdx.x);
        pg8::EpiG1 E{0, (bf16*)(ws + OFF_UA), (bf16*)(ws + OFF_UB), (bf16*)(ws + OFF_RAT), (bf16*)(ws + OFF_GB), (const float*)(ws + OFF_RS1), args.in[I_BGATE]};
#ifndef SKIP1
        pg8::gemm_phase<pg8::EpiG1, pg8::StaticOrder, PG8_ALIGN, PG8_SP2>(F.lds + RING_OFF, g, So, E);
#endif
    } SEAM(1);
#ifndef SKIP2
    if (IN(2)) { scan_phase<false>(F); } SEAM(2);
#endif
#ifndef SKIP3
    if (IN(3)) { carry_pool_phase(F); } SEAM(3);
#endif
#ifndef SKIP4
    if (IN(4)) { scan_phase<true>(F); } SEAM(4);
#endif
    if (IN(5)) {
        pg8::Gemm g{(const bf16*)(ws + OFF_HP), (const bf16*)(ws + OFF_BT2), M, D, KM}; pg8::StaticOrder So; So.init(M, D, F.G, (int)blockIdx.x);
        pg8::EpiMerge E{LW / 64, (const bf16*)(ws + OFF_RAT), (const bf16*)(ws + OFF_GB), (const float*)(ws + OFF_BC), (bf16*)(ws + OFF_MG)};
#ifndef SKIP5
        pg8::gemm_phase<pg8::EpiMerge, pg8::StaticOrder, PG8_ALIGN, PG8_SP2>(F.lds + RING_OFF, g, So, E);
#endif
    } SEAM(5);
    if (IN(6)) {
        pg8::Gemm g{(const bf16*)(ws + OFF_MG), (const bf16*)(ws + OFF_WO), M, D, D}; pg8::StaticOrder So; So.init(M, D, F.G, (int)blockIdx.x);
        pg8::EpiRes<true> E{0, args.in[I_X], args.out, (bf16*)(ws + OFF_X1B), (float*)(ws + OFF_PS2)};
#ifndef SKIP6
        pg8::gemm_phase<pg8::EpiRes<true>, pg8::StaticOrder, PG8_ALIGN, PG8_SP2>(F.lds + RING_OFF, g, So, E);
#endif
    } SEAM(6);
#pragma unroll 1
    for (int h = 0; h < 2; ++h) {
        if (IN(7 + 2 * h)) {
            pg8::Gemm g{(const bf16*)(ws + OFF_X1B) + (size_t)h * (M / 2) * D, (const bf16*)(ws + OFF_WUP), M / 2, FF2, D}; pg8::StaticOrder So; So.init(M / 2, FF2, F.G, (int)blockIdx.x);
            pg8::EpiUp E{0, (const float*)(ws + OFF_PS2) + (size_t)h * (M / 2) * 16, (bf16*)(ws + OFF_UP), FF2};
#ifndef SKIP7
            pg8::gemm_phase<pg8::EpiUp, pg8::StaticOrder, PG8_ALIGN, PG8_SP2>(F.lds + RING_OFF, g, So, E);
#endif
        } SEAM(7 + 2 * h);
#ifndef SKIP8
        if (IN(8 + 2 * h)) { act_phase(F, h * (M / 2)); } SEAM(8 + 2 * h);
#endif
    }
    if (IN(11)) {
        pg8::Gemm g{(const bf16*)(ws + OFF_ACT), (const bf16*)(ws + OFF_WD), M, D, FF}; pg8::StaticOrder So; So.init(M, D, F.G, (int)blockIdx.x);
        pg8::EpiRes<false> E{0, args.out, args.out, nullptr, (float*)(ws + OFF_PS3)};
#ifndef SKIP11
        pg8::gemm_phase<pg8::EpiRes<false>, pg8::StaticOrder, PG8_ALIGN, PG8_SP2>(F.lds + RING_OFF, g, So, E);
#endif
    } SEAM(11);
#ifndef SKIP12
    if (IN(12)) { final_phase(F); }
#endif
#undef IN
#undef SEAM
}

extern "C" void kernel_launch(void* const* d_in, const int* in_sizes, int n_in, void* d_out, int out_size, void* d_ws, size_t ws_size, hipStream_t stream) {
    static int grid = 0;
    if (grid == 0) {
        if (n_in != N_IN || in_sizes[0] != M * D || out_size != M * D || ws_size < WS_NEED) { fprintf(stderr, "kernel_launch: unexpected shapes: n_in %d in0 %d out %d ws %zu; nothing launched\n", n_in, n_in > 0 ? in_sizes[0] : -1, out_size, ws_size); grid = -1; return; }
        int dev = 0, cus = 0, per_cu = 0;
        if (hipGetDevice(&dev) != hipSuccess || hipDeviceGetAttribute(&cus, hipDeviceAttributeMultiprocessorCount, dev) != hipSuccess) { grid = -1; return; }
        if (hipFuncSetAttribute((const void*)mk_fwd, hipFuncAttributeMaxDynamicSharedMemorySize, LDS_BYTES) != hipSuccess) { fprintf(stderr, "kernel_launch: hipFuncSetAttribute failed\n"); grid = -1; return; }
        if (hipOccupancyMaxActiveBlocksPerMultiprocessor(&per_cu, (const void*)mk_fwd, NWAVES * 64, LDS_BYTES) != hipSuccess || per_cu < 1) { fprintf(stderr, "kernel_launch: occupancy query says %d blocks per CU\n", per_cu); per_cu = 1; }
        (void)hipGetLastError();
        grid = cus;
    }
    if (grid < 0) return;
    if (hipMemsetAsync((char*)d_ws + WS_CTL, 0, CTL_ZERO_BYTES, stream) != hipSuccess) { fprintf(stderr, "kernel_launch: memset failed\n"); return; }
    Args a{};
    for (int i = 0; i < N_IN; ++i) a.in[i] = (const float*)d_in[i];
    a.out = (float*)d_out; a.ws = (unsigned char*)d_ws;
    if (N_LAUNCHES == 1) { a.ph_lo = 0; a.ph_hi = N_PHASES; a.li = 0; hipLaunchKernelGGL(mk_fwd, dim3(grid), dim3(NWAVES * 64), LDS_BYTES, stream, a); }
    else for (int li = 0; li < N_PHASES; ++li) { a.ph_lo = li; a.ph_hi = li + 1; a.li = li; hipLaunchKernelGGL(mk_fwd, dim3(grid), dim3(NWAVES * 64), LDS_BYTES, stream, a); }
    const hipError_t le = hipPeekAtLastError();
    if (le != hipSuccess) fprintf(stderr, "kernel_launch: launch failed: %s\n", hipGetErrorName(le));
}
```

```cpp
#include <hip/hip_runtime.h>
#include <cstdio>
#include <cstdint>

#ifndef MK_N_LAUNCHES
#define MK_N_LAUNCHES 1
#endif
namespace pg8 {
#define PG8_LAS __attribute__((address_space(3)))
typedef unsigned short bf16_t;
typedef short bf16x8 __attribute__((ext_vector_type(8)));
typedef float f32x4 __attribute__((ext_vector_type(4)));
typedef unsigned u32x4 __attribute__((ext_vector_type(4)));
constexpr int BM = 256, BK = 64, HALF = 128, HTB = HALF * BK * 2  , STAGE_BYTES = 8 * HTB, NXCD = 8, WGM = 8;

__host__ __device__ __forceinline__ int lds_byte(int r, int c) { const int st = (r >> 4) * 2 + (c >> 5), rr = r & 15, cc = c & 31, ob = rr * 64 + cc * 2; return st * 1024 + (ob ^ (((ob >> 9) & 1) << 5)); }
__host__ __device__ __forceinline__ void stage_rc(int b, int& R, int& C) { const int st = b / 1024, sb = b % 1024, swz = sb ^ (((sb >> 9) & 1) << 5); R = (st >> 1) * 16 + swz / 64; C = (st & 1) * 32 + (swz % 64) / 2; }
__host__ __device__ __forceinline__ int perm32(int rho) { const int n = rho >> 4, i = rho & 15; return 8 * (i >> 2) + 4 * n + (i & 3); }

struct Unit { int pm, pn; };
struct Gemm { const bf16_t* A; const bf16_t* Bt; int M, N, K; };

struct StaticOrder {
    int nM, nN, nwg, G, c;
    __host__ __device__ void init(int M, int N, int G_, int c_) { nM = M / BM; nN = N / BM; nwg = nM * nN; G = G_; c = c_; }
    __host__ __device__ bool next(int i, Unit& u) const {
        const long L = (long)i * G + c; if (L >= nwg) return false;
        int wgid = (int)L; { const int q = nwg / NXCD, r = nwg % NXCD, xcd = wgid % NXCD, off = wgid / NXCD; wgid = (xcd < r ? xcd * (q + 1) : r * (q + 1) + (xcd - r) * q) + off; }
        const int nig = WGM * nN, gid = wgid / nig, fm = gid * WGM, gsz = (nM - fm) < WGM ? (nM - fm) : WGM;
        u.pm = fm + ((wgid % nig) % gsz); u.pn = (wgid % nig) / gsz; return true;
    }
    __device__ __forceinline__ void a_ready(const Unit&) const {}
    __device__ __forceinline__ void done(const Unit&) const {}
};

__device__ __forceinline__ unsigned cvt_pk_bf16(float lo, float hi) { unsigned r; asm volatile("v_cvt_pk_bf16_f32 %0, %1, %2" : "=v"(r) : "v"(lo), "v"(hi)); return r; }
__device__ __forceinline__ float bflo(unsigned w) { return __uint_as_float(w << 16); }
__device__ __forceinline__ float bfhi(unsigned w) { return __uint_as_float(w & 0xffff0000u); }
typedef unsigned u32x2 __attribute__((ext_vector_type(2)));
constexpr float LOG2E = 1.4426950408889634f;

struct EpiG1 {
    static constexpr bool PERM = true, AFTER_DRAIN = false, HAS_MID = false; int tmid;
    bf16_t* UA; bf16_t* UB; bf16_t* RAT; bf16_t* GB; const float* rs1; const float* bgate;
    __device__ __forceinline__ void mid(f32x4 (&)[2][2][4][2], const Unit&, int, int, int, int) const {}
    __device__ __forceinline__ void operator()(const f32x4 (&acc)[2][2][4][2], const Unit& u, int wr, int wc, int fr, int fq) const {
        const int row0_ = u.pm * BM + wr * 64 + fr;
        int row0 = row0_; asm volatile("" : "+v"(row0));
        if (u.pn < 9) {
            bf16_t* base; int ldc, colt;
            if (u.pn < 5) { base = UA; ldc = 1280; colt = u.pn * 256; } else { base = UB; ldc = 1024; colt = (u.pn - 5) * 256; }
            const int col0 = colt + wc * 32 + 8 * fq;
#pragma unroll
            for (int ai = 0; ai < 2; ++ai)
#pragma unroll
                for (int m = 0; m < 4; ++m) { const int row = row0 + ai * HALF + m * 16; const float rs = rs1[row]; bf16_t* rowp = base + (size_t)row * ldc + col0;
#pragma unroll
                    for (int bj = 0; bj < 2; ++bj) { const f32x4 v0 = acc[ai][bj][m][0] * rs, v1 = acc[ai][bj][m][1] * rs;
                        u32x4 w; w.x = cvt_pk_bf16(v0[0], v0[1]); w.y = cvt_pk_bf16(v0[2], v0[3]); w.z = cvt_pk_bf16(v1[0], v1[1]); w.w = cvt_pk_bf16(v1[2], v1[3]);
                        *(u32x4*)(rowp + bj * HALF) = w; } }
        } else {
            const int ch0 = (u.pn - 9) * 128 + wc * 32 + 8 * fq;
            f32x4 ba[2], bb[2];
#pragma unroll
            for (int n = 0; n < 2; ++n) { ba[n] = *(const f32x4*)(bgate + ch0 + 4 * n) * (-LOG2E); bb[n] = *(const f32x4*)(bgate + 1024 + ch0 + 4 * n) * (-LOG2E); }
#pragma unroll
            for (int ai = 0; ai < 2; ++ai)
#pragma unroll
                for (int m = 0; m < 4; ++m) { const int row = row0 + ai * HALF + m * 16; const float rs = rs1[row] * (-LOG2E);
                    float ra[8], gb[8];
#pragma unroll
                    for (int n = 0; n < 2; ++n)
#pragma unroll
                        for (int j = 0; j < 4; ++j) { const float ea = __builtin_amdgcn_exp2f(acc[ai][0][m][n][j] * rs + ba[n][j]); const float eb = fminf(__builtin_amdgcn_exp2f(acc[ai][1][m][n][j] * rs + bb[n][j]), 1e18f);
                            gb[4 * n + j] = __builtin_amdgcn_rcpf(1.0f + eb); ra[4 * n + j] = (1.0f + eb) * __builtin_amdgcn_rcpf(1.0f + ea); }
                    u32x4 w; w.x = cvt_pk_bf16(ra[0], ra[1]); w.y = cvt_pk_bf16(ra[2], ra[3]); w.z = cvt_pk_bf16(ra[4], ra[5]); w.w = cvt_pk_bf16(ra[6], ra[7]);
                    *(u32x4*)((char*)RAT + ((unsigned)row * 1024u + (unsigned)ch0) * 2u) = w;
                    w.x = cvt_pk_bf16(gb[0], gb[1]); w.y = cvt_pk_bf16(gb[2], gb[3]); w.z = cvt_pk_bf16(gb[4], gb[5]); w.w = cvt_pk_bf16(gb[6], gb[7]);
                    *(u32x4*)((char*)GB + ((unsigned)row * 1024u + (unsigned)ch0) * 2u) = w; }
        }
    }
};

struct EpiMerge {
    static constexpr bool PERM = true, AFTER_DRAIN = false, HAS_MID = true; int tmid;
    const bf16_t* RAT; const bf16_t* GB; const float* bc; bf16_t* MG;
    __device__ __forceinline__ void mid(f32x4 (&acc)[2][2][4][2], const Unit& u, int wr, int wc, int fr, int fq) const {
        const int row0_ = u.pm * BM + wr * 64 + fr, col0 = u.pn * BM + wc * 32 + 8 * fq;
        int row0 = row0_; asm volatile("" : "+v"(row0));
#pragma unroll
        for (int ai = 0; ai < 2; ++ai)
#pragma unroll
            for (int m = 0; m < 4; ++m) { const unsigned rb = ((unsigned)(row0 + ai * HALF + m * 16) * 1024u + (unsigned)col0) * 2u;
#pragma unroll
                for (int bj = 0; bj < 2; ++bj) { const u32x4 w = *(const u32x4*)((const char*)RAT + (rb + bj * HALF * 2u));
                    acc[ai][bj][m][0] *= (f32x4){bflo(w.x), bfhi(w.x), bflo(w.y), bfhi(w.y)}; acc[ai][bj][m][1] *= (f32x4){bflo(w.z), bfhi(w.z), bflo(w.w), bfhi(w.w)}; }
                asm volatile("" ::: "memory"); }
    }
    __device__ __forceinline__ void operator()(const f32x4 (&acc)[2][2][4][2], const Unit& u, int wr, int wc, int fr, int fq) const {
        const int row0_ = u.pm * BM + wr * 64 + fr, col0 = u.pn * BM + wc * 32 + 8 * fq;
        int row0 = row0_; asm volatile("" : "+v"(row0));
        f32x4 bv[2][2];
#pragma unroll
        for (int bj = 0; bj < 2; ++bj)
#pragma unroll
            for (int n = 0; n < 2; ++n) bv[bj][n] = *(const f32x4*)(bc + col0 + bj * HALF + 4 * n);
#pragma unroll
        for (int ai = 0; ai < 2; ++ai)
#pragma unroll
            for (int m = 0; m < 4; ++m) { const unsigned rb = ((unsigned)(row0 + ai * HALF + m * 16) * 1024u + (unsigned)col0) * 2u;
#pragma unroll
                for (int bj = 0; bj < 2; ++bj) { const u32x4 g = *(const u32x4*)((const char*)GB + (rb + bj * HALF * 2u));
                    const f32x4 v0 = (acc[ai][bj][m][0] + bv[bj][0]) * (f32x4){bflo(g.x), bfhi(g.x), bflo(g.y), bfhi(g.y)}, v1 = (acc[ai][bj][m][1] + bv[bj][1]) * (f32x4){bflo(g.z), bfhi(g.z), bflo(g.w), bfhi(g.w)};
                    u32x4 w; w.x = cvt_pk_bf16(v0[0], v0[1]); w.y = cvt_pk_bf16(v0[2], v0[3]); w.z = cvt_pk_bf16(v1[0], v1[1]); w.w = cvt_pk_bf16(v1[2], v1[3]);
                    *(u32x4*)((char*)MG + (rb + bj * HALF * 2u)) = w; }
                asm volatile("" ::: "memory"); }
    }
};

template <bool WRITE_BF> struct EpiRes {
    static constexpr bool PERM = false, AFTER_DRAIN = false, HAS_MID = false; int tmid;
    const float* xin; float* out; bf16_t* XB; float* PS;
    __device__ __forceinline__ void mid(f32x4 (&)[2][2][4][2], const Unit&, int, int, int, int) const {}
    __device__ __forceinline__ void operator()(const f32x4 (&acc)[2][2][4][2], const Unit& u, int wr, int wc, int fr, int fq) const {
        const int row0_ = u.pm * BM + wr * 64 + fr, col0 = u.pn * BM + wc * 32 + 4 * fq;
        int row0 = row0_; asm volatile("" : "+v"(row0));
#pragma unroll
        for (int ai = 0; ai < 2; ++ai)
#pragma unroll
            for (int m = 0; m < 4; ++m) { const int row = row0 + ai * HALF + m * 16; const unsigned off = (unsigned)row * 1024u + (unsigned)col0; float ss = 0.f;
#pragma unroll
                for (int bj = 0; bj < 2; ++bj)
#pragma unroll
                    for (int n = 0; n < 2; ++n) { const unsigned o = off + bj * HALF + n * 16; const f32x4 x1 = *(const f32x4*)((const char*)xin + o * 4u) + acc[ai][bj][m][n]; *(f32x4*)((char*)out + o * 4u) = x1;
                        ss += (x1[0] * x1[0] + x1[1] * x1[1]) + (x1[2] * x1[2] + x1[3] * x1[3]);
                        if (WRITE_BF) { u32x2 w; w.x = cvt_pk_bf16(x1[0], x1[1]); w.y = cvt_pk_bf16(x1[2], x1[3]); *(u32x2*)((char*)XB + o * 2u) = w; } }
                ss += __shfl_xor(ss, 16); ss += __shfl_xor(ss, 32);
                if (fq == 0) PS[(size_t)row * 16 + u.pn * 4 + wc] = ss; }
    }
};

struct EpiUp {
    static constexpr bool PERM = true, AFTER_DRAIN = false, HAS_MID = false; int tmid;
    const float* PS; bf16_t* UP; int ldc;
    __device__ __forceinline__ void mid(f32x4 (&)[2][2][4][2], const Unit&, int, int, int, int) const {}
    __device__ __forceinline__ void operator()(const f32x4 (&acc)[2][2][4][2], const Unit& u, int wr, int wc, int fr, int fq) const {
        const int row0_ = u.pm * BM + wr * 64 + fr, col0 = u.pn * BM + wc * 32 + 8 * fq;
        int row0 = row0_; asm volatile("" : "+v"(row0));
#pragma unroll
        for (int ai = 0; ai < 2; ++ai)
#pragma unroll
            for (int m = 0; m < 4; ++m) { const int row = row0 + ai * HALF + m * 16; const f32x4* ps = (const f32x4*)(PS + (size_t)row * 16);
                const f32x4 s4 = (ps[0] + ps[1]) + (ps[2] + ps[3]); const float rs = 1.0f / sqrtf(((s4[0] + s4[1]) + (s4[2] + s4[3])) * (1.0f / 1024.0f) + 1e-6f);
                bf16_t* rowp = UP + (size_t)row * ldc + col0;
#pragma unroll
                for (int bj = 0; bj < 2; ++bj) { const f32x4 v0 = acc[ai][bj][m][0] * rs, v1 = acc[ai][bj][m][1] * rs;
                    u32x4 w; w.x = cvt_pk_bf16(v0[0], v0[1]); w.y = cvt_pk_bf16(v0[2], v0[3]); w.z = cvt_pk_bf16(v1[0], v1[1]); w.w = cvt_pk_bf16(v1[2], v1[3]);
                    *(u32x4*)(rowp + bj * HALF) = w; } }
    }
};
template <class Epi, class Sched, bool ALIGN_EPI = false, bool SP2 = false>
__device__ __forceinline__ void gemm_phase(PG8_LAS unsigned char* lds, const Gemm g, const Sched& S, const Epi& E) {
    const int tid = threadIdx.x, wid = __builtin_amdgcn_readfirstlane(tid >> 6), lane = tid & 63, wr = wid >> 2, wc = wid & 3, fr = lane & 15, fq = lane >> 4;
    const int K = g.K, nt = K / BK;
    unsigned voffA[2], voffB[2];
#pragma unroll
    for (int i = 0; i < 2; ++i) { int R, C; stage_rc(tid * 16 + i * 8192, R, C); const int Rb = Epi::PERM ? ((R & ~31) + perm32(R & 31)) : R;
        voffA[i] = (unsigned)(R * K + C) * 2u; voffB[i] = (unsigned)(Rb * K + C) * 2u; }
    const size_t kstep = (size_t)(BK * 2);
    const size_t hstep = (size_t)HALF * K * 2;
    const size_t tstep = 2 * hstep;
    const unsigned ldsw = (unsigned)wid * 1024u;
    const int aoff = lds_byte(wr * 64 + fr, fq * 8), boff = lds_byte(wc * 32 + fr, fq * 8);
#define PG8_SA(b, h) (((b) * 2 + (h)) * HTB)
#define PG8_SB(b, h) ((4 + (b) * 2 + (h)) * HTB)
#define PG8_STAGE(bufoff, gbase, voff) do { _Pragma("unroll") for (int _i = 0; _i < 2; ++_i) \
        __builtin_amdgcn_global_load_lds((const unsigned*)((const char*)(gbase) + (voff)[_i]), (PG8_LAS unsigned*)(lds + (bufoff) + ldsw + _i * 8192), 16, 0, 0); } while (0)
#define PG8_LDA(dst, b, h) do { _Pragma("unroll") for (int m = 0; m < 4; ++m) _Pragma("unroll") for (int k = 0; k < 2; ++k) dst[m][k] = *(const PG8_LAS bf16x8*)(lds + PG8_SA(b, h) + aoff + m * 2048 + k * 1024); } while (0)
#define PG8_LDB(dst, b, h) do { _Pragma("unroll") for (int n = 0; n < 2; ++n) _Pragma("unroll") for (int k = 0; k < 2; ++k) dst[n][k] = *(const PG8_LAS bf16x8*)(lds + PG8_SB(b, h) + boff + n * 2048 + k * 1024); } while (0)
#define PG8_MMA(ai, bj, At, Bt) do { __builtin_amdgcn_s_setprio(1); _Pragma("unroll") for (int m = 0; m < 4; ++m) _Pragma("unroll") for (int n = 0; n < 2; ++n) _Pragma("unroll") for (int k = 0; k < 2; ++k) \
        acc[ai][bj][m][n] = __builtin_amdgcn_mfma_f32_16x16x32_bf16(Bt[n][k], At[m][k], acc[ai][bj][m][n], 0, 0, 0); __builtin_amdgcn_s_setprio(0); } while (0)
#define PG8_WAIT_V(n) asm volatile("s_waitcnt vmcnt(" #n ")" ::: "memory")
#define PG8_WAIT_L(n) asm volatile("s_waitcnt lgkmcnt(" #n ")" ::: "memory")
#define PG8_BAR __builtin_amdgcn_s_barrier()
#define PG8_SCHED __builtin_amdgcn_sched_barrier(0)
    Unit cur, nxt; int ui = 0;
    if (!S.next(0, cur)) return;
    f32x4 acc[2][2][4][2];
#pragma unroll
    for (int a = 0; a < 2; ++a)
#pragma unroll
        for (int b = 0; b < 2; ++b)
#pragma unroll
            for (int m = 0; m < 4; ++m)
#pragma unroll
                for (int n = 0; n < 2; ++n) acc[a][b][m][n] = (f32x4){0.f, 0.f, 0.f, 0.f};
    bf16x8 At[4][2], B0[2][2], B1[2][2];
    const char* cA = (const char*)g.A + (size_t)cur.pm * tstep; const char* cB = (const char*)g.Bt + (size_t)cur.pn * tstep;
    S.a_ready(cur);
    if constexpr (SP2) {
        PG8_STAGE(PG8_SB(0, 0), cB, voffB); PG8_STAGE(PG8_SB(0, 1), cB + hstep, voffB); PG8_STAGE(PG8_SA(0, 0), cA, voffA); PG8_STAGE(PG8_SA(0, 1), cA + hstep, voffA);
        if (wr == 1) PG8_BAR;
        PG8_WAIT_V(2); PG8_BAR;
        PG8_STAGE(PG8_SB(1, 0), cB + kstep, voffB); PG8_STAGE(PG8_SA(1, 0), cA + kstep, voffA); PG8_STAGE(PG8_SB(1, 1), cB + hstep + kstep, voffB);
        PG8_WAIT_V(6); PG8_BAR;
    } else {
        PG8_STAGE(PG8_SB(0, 0), cB, voffB); PG8_STAGE(PG8_SA(0, 0), cA, voffA); PG8_STAGE(PG8_SB(0, 1), cB + hstep, voffB); PG8_STAGE(PG8_SA(0, 1), cA + hstep, voffA);
        if (wr == 1) PG8_BAR;
        PG8_WAIT_V(4); PG8_BAR;
        PG8_STAGE(PG8_SB(1, 0), cB + kstep, voffB); PG8_STAGE(PG8_SA(1, 0), cA + kstep, voffA); PG8_STAGE(PG8_SB(1, 1), cB + hstep + kstep, voffB);
        PG8_WAIT_V(6); PG8_BAR;
    }
    for (;;) {
        const bool has_next = S.next(ui + 1, nxt);
        const char* nA = has_next ? (const char*)g.A + (size_t)nxt.pm * tstep : cA; const char* nB = has_next ? (const char*)g.Bt + (size_t)nxt.pn * tstep : cB;
#pragma unroll 1
        for (int part = 0; part < (Epi::HAS_MID ? 2 : 1); ++part) {
        const int tb_ = (Epi::HAS_MID && part == 1) ? E.tmid : 0, te_ = (Epi::HAS_MID && part == 0) ? E.tmid : nt;
#pragma unroll 1
        for (int t = tb_; t < te_; t += 2) {
            const bool last = (t == nt - 2);
            const char* a1 = cA + (size_t)(t + 1) * kstep;
            const char* a2 = last ? nA : cA + (size_t)(t + 2) * kstep; const char* b2 = last ? nB : cB + (size_t)(t + 2) * kstep;
            const char* a3 = a2 + kstep; const char* b3 = b2 + kstep;
            if (last && has_next) S.a_ready(nxt);
            if constexpr (SP2) {
            PG8_LDB(B0, 0, 0); PG8_LDB(B1, 0, 1); PG8_SCHED; PG8_LDA(At, 0, 0); PG8_STAGE(PG8_SA(1, 1), a1 + hstep, voffA);
            PG8_WAIT_V(8); PG8_WAIT_L(0); PG8_BAR; PG8_MMA(0, 0, At, B0); PG8_MMA(0, 1, At, B1); PG8_BAR; PG8_SCHED;
            PG8_LDA(At, 0, 1); PG8_STAGE(PG8_SB(0, 0), b2, voffB); PG8_STAGE(PG8_SB(0, 1), b2 + hstep, voffB); PG8_STAGE(PG8_SA(0, 0), a2, voffA);
            PG8_WAIT_V(8); PG8_WAIT_L(0); PG8_BAR; PG8_MMA(1, 0, At, B0); PG8_MMA(1, 1, At, B1); PG8_BAR; PG8_SCHED;
            PG8_LDB(B0, 1, 0); PG8_LDB(B1, 1, 1); PG8_SCHED; PG8_LDA(At, 1, 0); PG8_STAGE(PG8_SA(0, 1), a2 + hstep, voffA);
            PG8_WAIT_V(8); PG8_WAIT_L(0); PG8_BAR; PG8_MMA(0, 0, At, B0); PG8_MMA(0, 1, At, B1); PG8_BAR; PG8_SCHED;
            PG8_LDA(At, 1, 1); PG8_STAGE(PG8_SB(1, 0), b3, voffB); PG8_STAGE(PG8_SB(1, 1), b3 + hstep, voffB); PG8_STAGE(PG8_SA(1, 0), a3, voffA);
            PG8_WAIT_V(8); PG8_WAIT_L(0); PG8_BAR; PG8_MMA(1, 0, At, B0); PG8_MMA(1, 1, At, B1); PG8_BAR; PG8_SCHED;
            } else {
            PG8_LDB(B0, 0, 0); PG8_SCHED; PG8_LDA(At, 0, 0); PG8_STAGE(PG8_SA(1, 1), a1 + hstep, voffA);
            PG8_WAIT_L(8); PG8_BAR; PG8_WAIT_L(0); PG8_MMA(0, 0, At, B0); PG8_BAR; PG8_SCHED;
            PG8_LDB(B1, 0, 1); PG8_STAGE(PG8_SB(0, 0), b2, voffB);
            PG8_BAR; PG8_WAIT_L(0); PG8_MMA(0, 1, At, B1); PG8_BAR;
            PG8_LDA(At, 0, 1); PG8_STAGE(PG8_SA(0, 0), a2, voffA);
            PG8_BAR; PG8_WAIT_L(0); PG8_MMA(1, 0, At, B0); PG8_BAR; PG8_SCHED;
            PG8_STAGE(PG8_SB(0, 1), b2 + hstep, voffB);
            PG8_WAIT_V(6); PG8_BAR; PG8_MMA(1, 1, At, B1); PG8_BAR;
            PG8_LDB(B0, 1, 0); PG8_SCHED; PG8_LDA(At, 1, 0); PG8_STAGE(PG8_SA(0, 1), a2 + hstep, voffA);
            PG8_WAIT_L(8); PG8_BAR; PG8_WAIT_L(0); PG8_MMA(0, 0, At, B0); PG8_BAR; PG8_SCHED;
            PG8_LDB(B1, 1, 1); PG8_STAGE(PG8_SB(1, 0), b3, voffB);
            PG8_BAR; PG8_WAIT_L(0); PG8_MMA(0, 1, At, B1); PG8_BAR;
            PG8_LDA(At, 1, 1); PG8_STAGE(PG8_SA(1, 0), a3, voffA);
            PG8_BAR; PG8_WAIT_L(0); PG8_MMA(1, 0, At, B0); PG8_BAR; PG8_SCHED;
            PG8_STAGE(PG8_SB(1, 1), b3 + hstep, voffB);
            PG8_WAIT_V(6); PG8_BAR; PG8_MMA(1, 1, At, B1); PG8_BAR;
            }
        }
        if constexpr (Epi::HAS_MID) { if (part == 0) E.mid(acc, cur, wr, wc, fr, fq); }
        }
        if constexpr (ALIGN_EPI) { if (wr == 0) PG8_BAR; }
        if constexpr (!Epi::AFTER_DRAIN) { E(acc, cur, wr, wc, fr, fq); S.done(cur); }
        if (!has_next) break;
#pragma unroll
        for (int a = 0; a < 2; ++a)
#pragma unroll
            for (int b = 0; b < 2; ++b)
#pragma unroll
                for (int m = 0; m < 4; ++m)
#pragma unroll
                    for (int n = 0; n < 2; ++n) acc[a][b][m][n] = (f32x4){0.f, 0.f, 0.f, 0.f};
        cur = nxt; cA = nA; cB = nB; ++ui;
        if constexpr (ALIGN_EPI) { if (wr == 1) PG8_BAR; }
    }
    PG8_WAIT_V(0);
    if constexpr (!ALIGN_EPI) { if (wr == 0) PG8_BAR; }
    PG8_BAR;
    if constexpr (Epi::AFTER_DRAIN) { E.fused(acc, cur, wr, wc, fr, fq, lds, wid, lane); S.done(cur); }
#undef PG8_SA
#undef PG8_SB
#undef PG8_STAGE
#undef PG8_LDA
#undef PG8_LDB
#undef PG8_MMA
#undef PG8_WAIT_V
#undef PG8_WAIT_L
#undef PG8_BAR
#undef PG8_SCHED
}
}
#ifndef PG8_SP2
#define PG8_SP2 true
#endif
#ifndef PG8_ALIGN
#define PG8_ALIGN true
#endif
constexpr int NWAVES = 8;
constexpr int N_LAUNCHES = MK_N_LAUNCHES;
constexpr int N_PHASES = 13;
constexpr int NB = 4, S = 8192, D = 1024, M = NB * S;
constexpr int LW = 1280, NH = 10, HD = 128, PW = 1024, INW = 4352, FF = 2816, FF2 = 5632, KM = LW + PW  ;
constexpr float EPS = 1e-6f;
constexpr int SEG = 16, NSEG = S / SEG;
constexpr int TC = 256, NCHUNK = S / TC;
constexpr size_t MiB = 1u << 20;
constexpr size_t WS_CTL = 0, CTL_ZERO_BYTES = 64 * 1024;
constexpr size_t OFF_WIN = 1 * MiB;
constexpr size_t OFF_WUP = 10 * MiB;
constexpr size_t OFF_WD = 21 * MiB;
constexpr size_t OFF_BT2 = 27 * MiB;
constexpr size_t OFF_WO = 32 * MiB;
constexpr size_t OFF_WG = 34 * MiB;
constexpr size_t OFF_RS1 = 36 * MiB;
constexpr size_t OFF_BC = OFF_RS1 + 128 * 1024;
constexpr size_t OFF_LAMC = OFF_BC + 4096;
constexpr size_t OFF_PS2 = 38 * MiB;
constexpr size_t OFF_PS3 = 40 * MiB;
constexpr size_t OFF_UA = 48 * MiB;
constexpr size_t OFF_X1B = 48 * MiB;
constexpr size_t OFF_UB = 128 * MiB;
constexpr size_t OFF_MG = 128 * MiB;
constexpr size_t OFF_RAT = 192 * MiB;
constexpr size_t OFF_GB = 256 * MiB;
constexpr size_t OFF_HP = 320 * MiB;
constexpr size_t OFF_XB = 448 * MiB;
constexpr size_t OFF_UP = 112 * MiB;
constexpr size_t OFF_ACT = 288 * MiB;
constexpr size_t WS_NEED = 512 * MiB;
constexpr size_t DO_CAR = 0, DO_HIN = 40 * MiB;
constexpr int CW_TMO = 0, CW_BAR = 4096;
constexpr int RING_OFF = 0, RING_BYTES = 131072;
constexpr int LDSCTL_OFF = RING_BYTES, MISC_OFF = LDSCTL_OFF + 320;
constexpr int LDS_BYTES = 147456;
enum { I_X = 0, I_GMIX, I_WIN, I_BGATE, I_CAW, I_CAB, I_WAF, I_BAF, I_WXF, I_BXF, I_LAMF, I_WAB, I_BAB, I_WXB, I_BXB, I_LAMB,
       I_WPOOL, I_BPOOL, I_PSCALE, I_PA, I_PB, I_WOUT, I_GFFN, I_WUP, I_CFW, I_CFB, I_WDOWN, I_GFINAL, N_IN };

#define GAS __attribute__((address_space(1)))
#define LAS __attribute__((address_space(3)))
typedef unsigned short bf16;
typedef unsigned v4u __attribute__((ext_vector_type(4)));
typedef float f32x4 __attribute__((ext_vector_type(4)));
typedef float f32x2 __attribute__((ext_vector_type(2)));
typedef float f32x16 __attribute__((ext_vector_type(16)));
typedef short bf16x8 __attribute__((ext_vector_type(8)));
typedef GAS unsigned gu32;
#define RLX_AGENT __ATOMIC_RELAXED, __HIP_MEMORY_SCOPE_AGENT
#define LDS_WAIT() asm volatile("s_waitcnt lgkmcnt(0)" ::: "memory")
#define VM_WAIT() asm volatile("s_waitcnt vmcnt(0)" ::: "memory")
__device__ __forceinline__ unsigned f2bf(float f) { unsigned u = __builtin_bit_cast(unsigned, f); return (u + 0x7fffu + ((u >> 16) & 1u)) >> 16; }
__device__ __forceinline__ unsigned pk2(float lo, float hi) { return f2bf(lo) | (f2bf(hi) << 16); }
__device__ __forceinline__ float bflo(unsigned w) { return __uint_as_float(w << 16); }
__device__ __forceinline__ float bfhi(unsigned w) { return __uint_as_float(w & 0xffff0000u); }
constexpr float LOG2E = 1.4426950408889634f;
#define XB_TMO      128
#define XB_XCNT(j)  (256  + 64 * (j))
#define XB_XSUB(j)  (1280 + 64 * (j))
#define XB_XGEN(j)  (2304 + 64 * (j))
#define XB_TOP      3328
#define XB_TOPGEN   3392
#define XCD_BAR_WORDS 3456
#define XB_SPIN_CAP (1u << 18)

__device__ __forceinline__ unsigned xb_ld(unsigned* p)              { return __hip_atomic_load(p, __ATOMIC_RELAXED, __HIP_MEMORY_SCOPE_AGENT); }
__device__ __forceinline__ unsigned xb_add(unsigned* p, unsigned v) { return __hip_atomic_fetch_add(p, v, __ATOMIC_RELAXED, __HIP_MEMORY_SCOPE_AGENT); }
__device__ __forceinline__ unsigned xb_xcc_id() { return (unsigned)__builtin_amdgcn_s_getreg((3 << 11) | 20) & 0xFu; }
#define XB_SPIN(cond, bar) do { unsigned _sp = 0; while (cond) { __builtin_amdgcn_s_sleep(1); \
    if ((++_sp & 255u) == 0u) { if (xb_ld(&(bar)[XB_TMO])) break; if (_sp > XB_SPIN_CAP) { atomicAdd(&(bar)[XB_TMO], 1u); break; } } } } while (0)

struct XcdBarrier {
    unsigned* bar; unsigned x;
    volatile LAS unsigned* st;
};

__device__ __forceinline__ XcdBarrier xcd_barrier_post(unsigned* bar, volatile LAS unsigned* st) {
    XcdBarrier b; b.bar = bar; b.x = xb_xcc_id(); b.st = st;
    if (threadIdx.x == 0) (void)xb_add(&bar[XB_XCNT(b.x)], 1u);
    return b;
}
__device__ __forceinline__ void xcd_barrier_complete(unsigned* bar, unsigned x, unsigned& nloc, unsigned& nx) {
    const unsigned G = gridDim.x * gridDim.y * gridDim.z;
    unsigned sum, cnt, mine, sp = 0u;
    for (;;) {
        sum = 0u; cnt = 0u; mine = 0u;
#pragma unroll
        for (unsigned j = 0; j < 16; ++j) { const unsigned c = xb_ld(&bar[XB_XCNT(j)]); sum += c; cnt += (c > 0u) ? 1u : 0u; mine = (j == x) ? c : mine; }
        if (sum == G) break;
        __builtin_amdgcn_s_sleep(1);
        if ((++sp & 255u) == 0u) { if (xb_ld(&bar[XB_TMO])) break; if (sp > XB_SPIN_CAP) { atomicAdd(&bar[XB_TMO], 1u); break; } }
    }
    nloc = mine > 0u ? mine : 1u; nx = cnt > 0u ? cnt : 1u;
}

__device__ __forceinline__ void xcd_barrier(const XcdBarrier& b) {
    asm volatile("s_waitcnt vmcnt(0)" ::: "memory");
    __syncthreads();
    if (threadIdx.x == 0) {
        unsigned* bar = b.bar;
        __builtin_amdgcn_s_waitcnt(0);
        unsigned nloc = b.st[0], nx = b.st[1];
        if (nloc == 0u) { xcd_barrier_complete(bar, b.x, nloc, nx); b.st[0] = nloc; b.st[1] = nx; }
        const unsigned old = xb_add(&bar[XB_XSUB(b.x)], 1u);
        const unsigned gen = old / nloc;
        if (old + 1u == (gen + 1u) * nloc) {
            __builtin_amdgcn_fence(__ATOMIC_RELEASE, "agent");
            asm volatile("s_waitcnt vmcnt(0)" ::: "memory");
            const unsigned og = xb_add(&bar[XB_TOP], 1u);
            const unsigned tg = og / nx;
            if (og + 1u == (tg + 1u) * nx) xb_add(&bar[XB_TOPGEN], 1u);
            else XB_SPIN(xb_ld(&bar[XB_TOPGEN]) == tg, bar);
            __builtin_amdgcn_fence(__ATOMIC_ACQUIRE, "agent");
            xb_add(&bar[XB_XGEN(b.x)], 1u);
            asm volatile("s_waitcnt vmcnt(0)" ::: "memory");
        } else {
            XB_SPIN(xb_ld(&bar[XB_XGEN(b.x)]) == gen, bar);
            __builtin_amdgcn_fence(__ATOMIC_ACQUIRE, "agent");
            asm volatile("s_waitcnt vmcnt(0)" ::: "memory");
        }
    }
    __syncthreads();
}
struct Frame {
    LAS unsigned char* lds;
    volatile LAS unsigned* MISC;
    gu32* ctl;
    int tid, lane, wave;
    int vcu, G;
    const float* in[N_IN];
    float* out; unsigned char* ws;
};
__device__ __forceinline__ float wave_sum(float v) {
#pragma unroll
    for (int o = 1; o < 64; o <<= 1) v += __shfl_xor(v, o);
    return v;
}

__device__ __forceinline__ void p0_transpose_item(const float* W, int N, const float* kscale, bf16* dst_row0  , int ldk, int k0, int n0, int swz, LAS float* scr, int lane) {
#pragma unroll 8
    for (int i = 0; i < 32; ++i) { const int kk = 2 * i + (lane >> 5); float v = W[(size_t)(k0 + kk) * N + n0 + (lane & 31)]; if (kscale) v *= kscale[k0 + kk]; scr[kk * 33 + (lane & 31)] = v; }
    LDS_WAIT(); asm volatile("" ::: "memory");
    const int c = lane & 7;
#pragma unroll
    for (int j = 0; j < 4; ++j) { const int n = (lane >> 3) + 8 * j; const LAS float* s = scr + (8 * c) * 33 + n;
        v4u o; o.x = pk2(s[0 * 33], s[1 * 33]); o.y = pk2(s[2 * 33], s[3 * 33]); o.z = pk2(s[4 * 33], s[5 * 33]); o.w = pk2(s[6 * 33], s[7 * 33]);
        int chunk = (k0 >> 3) + c; if (swz) chunk ^= (n0 + n) & 15;
        *(GAS v4u*)(dst_row0 + (size_t)n * ldk + chunk * 8) = o; }
    LDS_WAIT(); asm volatile("" ::: "memory");
}
__device__ __forceinline__ void p0_prologue(Frame& F) {
    LAS float* scr = (LAS float*)(F.lds + RING_OFF + F.wave * 16384);
    const int gw = F.vcu * NWAVES + F.wave, NGW = F.G * NWAVES;
    bf16* WinT = (bf16*)(F.ws + OFF_WIN); bf16* WupT = (bf16*)(F.ws + OFF_WUP); bf16* WdT = (bf16*)(F.ws + OFF_WD); bf16* BT2 = (bf16*)(F.ws + OFF_BT2);
    bf16* WoT = (bf16*)(F.ws + OFF_WO); bf16* WgT = (bf16*)(F.ws + OFF_WG);
    constexpr int I_IN = (D / 64) * (INW / 32), I_UP = (D / 64) * (FF2 / 32), I_DN = (FF / 64) * (D / 32), I_PAI = (LW / 64) * (D / 32), I_WOI = (D / 64) * (D / 32), I_G = NH * 4 * 2 * 4;
    constexpr int NITEMS = I_IN + I_UP + I_DN + I_PAI + I_WOI + I_G;
    for (int it = gw; it < NITEMS; it += NGW) {
        int r = it;
        if (r < I_IN) { const int nblk = INW / 32, kb = r / nblk, n0 = (r % nblk) * 32; int drow = n0;
            if (n0 >= LW + PW) { const int c2 = n0 - (LW + PW), bj = c2 >> 10, ch = c2 & 1023; drow = LW + PW + 256 * (ch >> 7) + 128 * bj + (ch & 127); }
            p0_transpose_item(F.in[I_WIN], INW, F.in[I_GMIX], WinT + (size_t)drow * D, D, 64 * kb, n0, 0, scr, F.lane); continue; } r -= I_IN;
        if (r < I_UP) { const int nblk = FF2 / 32, kb = r / nblk, n0 = (r % nblk) * 32; const int bj = n0 / FF, ch = n0 % FF; const int drow = 256 * (ch >> 7) + 128 * bj + (ch & 127);
            p0_transpose_item(F.in[I_WUP], FF2, F.in[I_GFFN], WupT + (size_t)drow * D, D, 64 * kb, n0, 0, scr, F.lane); continue; } r -= I_UP;
        if (r < I_DN) { const int nblk = D / 32, kb = r / nblk, n0 = (r % nblk) * 32;
            p0_transpose_item(F.in[I_WDOWN], D, nullptr, WdT + (size_t)n0 * FF, FF, 64 * kb, n0, 0, scr, F.lane); continue; } r -= I_DN;
        if (r < I_PAI) { const int nblk = D / 32, kb = r / nblk, n0 = (r % nblk) * 32;
            p0_transpose_item(F.in[I_PA], D, nullptr, BT2 + (size_t)n0 * KM, KM, 64 * kb, n0, 0, scr, F.lane); continue; } r -= I_PAI;
        if (r < I_WOI) { const int nblk = D / 32, kb = r / nblk, n0 = (r % nblk) * 32;
            p0_transpose_item(F.in[I_WOUT], D, nullptr, WoT + (size_t)n0 * D, D, 64 * kb, n0, 0, scr, F.lane); continue; } r -= I_WOI;
        {
            const int hd = r / 32, g = (r >> 3) & 3, kb = (r >> 2) & 1, n0 = (r & 3) * 32;
            const float* src = (g == 0 ? F.in[I_WAF] : g == 1 ? F.in[I_WXF] : g == 2 ? F.in[I_WAB] : F.in[I_WXB]) + (size_t)hd * HD * HD;
            p0_transpose_item(src, HD, nullptr, WgT + ((size_t)hd * 512 + g * 128 + n0) * HD, HD, 64 * kb, n0, 1, scr, F.lane); }
    }
    const int gt = F.vcu * (NWAVES * 64) + F.tid, NGT = F.G * NWAVES * 64;
    for (int i = gt; i < D * PW; i += NGT) { const int n = i >> 10, k = i & 1023, g = k >> 8, kk = k & 255;
        const float* wp = F.in[I_WPOOL] + (size_t)g * 65536 + kk * 256; const float* sc = F.in[I_PSCALE] + g * 256; const float* pb = F.in[I_PB] + (size_t)(g * 256) * D + n;
        float s = 0.f;
#pragma unroll 8
        for (int j = 0; j < 256; ++j) s += wp[j] * sc[j] * pb[(size_t)j * D];
        BT2[(size_t)n * KM + LW + k] = (bf16)f2bf(s); }
    if (gt < D) { float s = 0.f;
#pragma unroll 8
        for (int c = 0; c < PW; ++c) s += F.in[I_BPOOL][c] * F.in[I_PSCALE][c] * F.in[I_PB][(size_t)c * D + gt];
        ((float*)(F.ws + OFF_BC))[gt] = s; }
    if (gt >= D && gt < D + 2 * LW) { const int i = gt - D; const float lam = (i < LW ? F.in[I_LAMF] : F.in[I_LAMB])[i % LW]; ((float*)(F.ws + OFF_LAMC))[i] = -8.0f * LOG2E * log1pf(expf(-lam)); }
    float* rs1 = (float*)(F.ws + OFF_RS1); bf16* XB = (bf16*)(F.ws + OFF_XB);
    for (int m = gw; m < M; m += NGW) {
        const GAS f32x4* xr = (const GAS f32x4*)(F.in[I_X] + (size_t)m * D) + F.lane;
        f32x4 v[4]; float s = 0.f;
#pragma unroll
        for (int j = 0; j < 4; ++j) { v[j] = xr[64 * j]; s += (v[j].x * v[j].x + v[j].y * v[j].y) + (v[j].z * v[j].z + v[j].w * v[j].w); }
        s = wave_sum(s);
        if (F.lane == 0) rs1[m] = 1.0f / sqrtf(s * (1.0f / D) + EPS);
        GAS unsigned long long* o8 = (GAS unsigned long long*)(XB + (size_t)m * D) + F.lane;
#pragma unroll
        for (int j = 0; j < 4; ++j) o8[64 * j] = (unsigned long long)pk2(v[j].x, v[j].y) | ((unsigned long long)pk2(v[j].z, v[j].w) << 32);
    }
}

template <bool FINAL>
__device__ __forceinline__ void scan_phase(Frame& F) {
    const int tid = F.tid, lane = F.lane, w = F.wave, c31 = lane & 31, hi = lane >> 5;
    LAS unsigned char* xat = F.lds + RING_OFF;
    LAS unsigned char* bbuf = F.lds + RING_OFF + 65536;
    const bf16* UA = (const bf16*)(F.ws + OFF_UA); const unsigned char* WgT = F.ws + OFF_WG; const float* lamc = (const float*)(F.ws + OFF_LAMC);
    f32x2* CAR = (f32x2*)((unsigned char*)F.out + DO_CAR); const float* HIN = (const float*)((unsigned char*)F.out + DO_HIN); bf16* HP = (bf16*)(F.ws + OFF_HP);
    const int NITEM = NB * NCHUNK * NH;
    const int tau = (c31 & 3) + 4 * (c31 >> 3) + 16 * ((c31 >> 2) & 1);
    const int arow = 32 * w + tau;
    const unsigned ldsw = (unsigned)w * 1024u;
#define SC_BGLDS(hd_, q_, buf_) do { _Pragma("unroll") for (int i_ = 0; i_ < 4; ++i_) { const int p_ = tid + 512 * i_, nl_ = p_ >> 4, ch_ = p_ & 15; const int ng_ = (nl_ >> 5) * 128 + 32 * (q_) + (nl_ & 31); \
        __builtin_amdgcn_global_load_lds((const unsigned*)(WgT + ((size_t)(hd_) * 512 + ng_) * 256 + ch_ * 16), (LAS unsigned*)(bbuf + (buf_) * 32768 + i_ * 8192 + ldsw), 16, 0, 0); } } while (0)
    int cur = 0; bool first = true;
    for (int it = F.vcu; it < NITEM; it += F.G) {
        const int hd = it % NH, bc_ = it / NH, b = bc_ / NCHUNK, t0 = (bc_ % NCHUNK) * TC;
        if (first) { SC_BGLDS(hd, 0, 0); cur = 0; first = false; }
        {
            const int cc = tid & 15, tg = tid >> 4;
            const int chg = hd * HD + 8 * cc;
            f32x4 wv[4][2], cb[2];
#pragma unroll
            for (int k = 0; k < 4; ++k) { wv[k][0] = *(const GAS f32x4*)(F.in[I_CAW] + k * LW + chg); wv[k][1] = *(const GAS f32x4*)(F.in[I_CAW] + k * LW + chg + 4); }
            cb[0] = *(const GAS f32x4*)(F.in[I_CAB] + chg); cb[1] = *(const GAS f32x4*)(F.in[I_CAB] + chg + 4);
            v4u u[11];
#pragma unroll
            for (int i = 0; i < 11; ++i) { const int t = t0 + 8 * tg - 2 + i; u[i] = (v4u){0u, 0u, 0u, 0u};
                if (t >= 0 && t < S) u[i] = *(const GAS v4u*)(UA + ((size_t)b * S + t) * LW + chg); }
#pragma unroll
            for (int tt = 0; tt < 8; ++tt) { f32x4 a0 = cb[0], a1 = cb[1];
#pragma unroll
                for (int k = 0; k < 4; ++k) { const v4u x = u[tt + k];
                    a0 += wv[k][0] * (f32x4){bflo(x.x), bfhi(x.x), bflo(x.y), bfhi(x.y)}; a1 += wv[k][1] * (f32x4){bflo(x.z), bfhi(x.z), bflo(x.w), bfhi(x.w)}; }
                const int row = 8 * tg + tt; v4u o; o.x = pk2(a0[0], a0[1]); o.y = pk2(a0[2], a0[3]); o.z = pk2(a1[0], a1[1]); o.w = pk2(a1[2], a1[3]);
                *(LAS v4u*)(xat + row * 256 + ((cc ^ (row & 15)) << 4)) = o; }
        }
        VM_WAIT(); LDS_WAIT(); __builtin_amdgcn_s_barrier(); asm volatile("" ::: "memory");
        bf16x8 af[8];
#pragma unroll
        for (int ks = 0; ks < 8; ++ks) af[ks] = *(const LAS bf16x8*)(xat + arow * 256 + (((2 * ks + hi) ^ (arow & 15)) << 4));
#pragma unroll 1
        for (int q = 0; q < 4; ++q) {
            { const int itn = it + F.G; if (q < 3) SC_BGLDS(hd, q + 1, cur ^ 1); else if (itn < NITEM) SC_BGLDS(itn % NH, 0, cur ^ 1); }
            const int cl = 32 * q + c31, cg = hd * HD + cl, seg = (t0 + 32 * w + 16 * hi) / SEG;
            float xa[16];
#pragma unroll
            for (int r = 0; r < 16; ++r) { const int row = 32 * w + 16 * hi + r; xa[r] = __uint_as_float((unsigned)(*(const LAS unsigned short*)(xat + row * 256 + (((cl >> 3) ^ r) << 4) + (cl & 7) * 2)) << 16); }
            float hsum[16];
#pragma unroll
            for (int dir = 0; dir < 2; ++dir) {
                f32x16 ga, gx;
#pragma unroll
                for (int r = 0; r < 16; ++r) { ga[r] = 0.f; gx[r] = 0.f; }
#pragma unroll
                for (int ks = 0; ks < 8; ++ks) { const int na = 32 * (2 * dir) + c31, nx = na + 32;
                    const bf16x8 ba_ = *(const LAS bf16x8*)(bbuf + cur * 32768 + na * 256 + (((2 * ks + hi) ^ (na & 15)) << 4));
                    const bf16x8 bx_ = *(const LAS bf16x8*)(bbuf + cur * 32768 + nx * 256 + (((2 * ks + hi) ^ (nx & 15)) << 4));
                    ga = __builtin_amdgcn_mfma_f32_32x32x16_bf16(af[ks], ba_, ga, 0, 0, 0); gx = __builtin_amdgcn_mfma_f32_32x32x16_bf16(af[ks], bx_, gx, 0, 0, 0); }
                const float nba = -LOG2E * (dir ? F.in[I_BAB] : F.in[I_BAF])[cg], nbx = -LOG2E * (dir ? F.in[I_BXB] : F.in[I_BXF])[cg], lc2 = lamc[dir * LW + cg];
                float av[16], bv[16];
#pragma unroll
                for (int r = 0; r < 16; ++r) {
                    const float er = __builtin_amdgcn_exp2f(ga[r] * (-LOG2E) + nba), rg = __builtin_amdgcn_rcpf(1.0f + er);
                    const float a = __builtin_amdgcn_exp2f(lc2 * rg);
                    const float ei = __builtin_amdgcn_exp2f(gx[r] * (-LOG2E) + nbx), ig = __builtin_amdgcn_rcpf(1.0f + ei);
                    av[r] = a; bv[r] = __builtin_amdgcn_sqrtf(fmaxf(1.0f - a * a, 0.f)) * (ig * xa[r]); }
                if (!FINAL) {
                    float A = 1.f, Bv = 0.f;
#pragma unroll
                    for (int i = 0; i < 16; ++i) { const int r = dir ? 15 - i : i; Bv = av[r] * Bv + bv[r]; A *= av[r]; }
                    CAR[(((size_t)dir * NB + b) * NSEG + seg) * LW + cg] = (f32x2){A, Bv};
                } else {
                    float h = HIN[(((size_t)dir * NB + b) * NSEG + seg) * LW + cg];
#pragma unroll
                    for (int i = 0; i < 16; ++i) { const int r = dir ? 15 - i : i; h = av[r] * h + bv[r]; if (dir == 0) hsum[r] = h; else hsum[r] += h; }
                }
            }
            if (FINAL) {
#pragma unroll
                for (int r = 0; r < 16; ++r) { const int row = 32 * w + 16 * hi + r; *(LAS unsigned short*)(xat + row * 256 + (((cl >> 3) ^ r) << 4) + (cl & 7) * 2) = (unsigned short)f2bf(hsum[r]); }
            }
            VM_WAIT(); LDS_WAIT(); __builtin_amdgcn_s_barrier(); asm volatile("" ::: "memory");
            cur ^= 1;
        }
        if (FINAL) {
#pragma unroll
            for (int i = 0; i < 8; ++i) { const int p = tid + 512 * i, row = p >> 4, chs = p & 15; const v4u v = *(const LAS v4u*)(xat + row * 256 + (chs << 4));
                *(GAS v4u*)(HP + ((size_t)b * S + t0 + row) * KM + hd * HD + ((chs ^ (row & 15)) << 3)) = v; }
            LDS_WAIT(); __builtin_amdgcn_s_barrier(); asm volatile("" ::: "memory");
        }
    }
#undef SC_BGLDS
}

__device__ __forceinline__ void carry_pool_phase(Frame& F) {
    {
        const f32x2* CAR = (const f32x2*)((unsigned char*)F.out + DO_CAR); float* HIN = (float*)((unsigned char*)F.out + DO_HIN);
        LAS f32x2* sh = (LAS f32x2*)(F.lds + RING_OFF);
        for (int task = F.vcu; task < 2 * NB * (LW / 64); task += F.G) {
            const int cgp = task % (LW / 64), db = task / (LW / 64), dir = db / NB, ss = F.tid >> 6, c = cgp * 64 + F.lane;
            const size_t base = (size_t)db * NSEG * LW + c;
            const long sstep = dir ? -(long)LW : (long)LW; const f32x2* cp = CAR + base + (size_t)(dir ? (NSEG - 1 - ss * 64) : ss * 64) * LW;
            float A = 1.f, Bv = 0.f;
#pragma unroll 16
            for (int i = 0; i < 64; ++i) { const f32x2 ab = cp[(long)i * sstep]; Bv = ab.x * Bv + ab.y; A *= ab.x; }
            sh[ss * 64 + F.lane] = (f32x2){A, Bv};
            LDS_WAIT(); __builtin_amdgcn_s_barrier(); asm volatile("" ::: "memory");
            float h = 0.f;
            for (int s2 = 0; s2 < ss; ++s2) { const f32x2 t = sh[s2 * 64 + F.lane]; h = t.x * h + t.y; }
            float* hp = HIN + base + (size_t)(dir ? (NSEG - 1 - ss * 64) : ss * 64) * LW;
#pragma unroll 16
            for (int i = 0; i < 64; ++i) { const f32x2 ab = cp[(long)i * sstep]; hp[(long)i * sstep] = h; h = ab.x * h + ab.y; }
            LDS_WAIT(); __builtin_amdgcn_s_barrier(); asm volatile("" ::: "memory");
        }
    }
    {
        const bf16* UB = (const bf16*)(F.ws + OFF_UB); bf16* HP = (bf16*)(F.ws + OFF_HP);
        const int gt = F.vcu * (NWAVES * 64) + F.tid, NGT = F.G * NWAVES * 64;
        for (int item = gt; item < (M / 32) * (PW / 8); item += NGT) {
            const int cc = item & 127, tb = item >> 7, b = tb / (S / 32), t0 = (tb % (S / 32)) * 32, g = cc >> 5, hw = 1 << g;
            const bf16* ub = UB + (size_t)b * S * PW + cc * 8;
            float sum[8];
#pragma unroll
            for (int j = 0; j < 8; ++j) sum[j] = 0.f;
#define PL_ADD(t_, sgn_) do { const int tq_ = (t_); if (tq_ >= 0 && tq_ < S) { const v4u x_ = *(const GAS v4u*)(ub + (size_t)tq_ * PW); \
                sum[0] += (sgn_) * bflo(x_.x); sum[1] += (sgn_) * bfhi(x_.x); sum[2] += (sgn_) * bflo(x_.y); sum[3] += (sgn_) * bfhi(x_.y); sum[4] += (sgn_) * bflo(x_.z); sum[5] += (sgn_) * bfhi(x_.z); sum[6] += (sgn_) * bflo(x_.w); sum[7] += (sgn_) * bfhi(x_.w); } } while (0)
            for (int t = t0 - hw; t <= t0 + hw - 1; ++t) PL_ADD(t, 1.f);
            for (int i = 0; i < 32; ++i) { const int t = t0 + i;
                const int lo = max(t - hw, 0), hi = min(t + hw - 1, S - 1); const float inv = 1.0f / (float)(hi - lo + 1);
                const v4u x = *(const GAS v4u*)(ub + (size_t)t * PW);
                v4u o; o.x = pk2(sum[0] * inv - bflo(x.x), sum[1] * inv - bfhi(x.x)); o.y = pk2(sum[2] * inv - bflo(x.y), sum[3] * inv - bfhi(x.y));
                o.z = pk2(sum[4] * inv - bflo(x.z), sum[5] * inv - bfhi(x.z)); o.w = pk2(sum[6] * inv - bflo(x.w), sum[7] * inv - bfhi(x.w));
                *(GAS v4u*)(HP + ((size_t)b * S + t) * KM + LW + cc * 8) = o;
                PL_ADD(t + hw, 1.f); PL_ADD(t - hw, -1.f); }
        }
    }
}

__device__ __forceinline__ void act_phase(Frame& F, int rowbase) {
    const bf16* UP = (const bf16*)(F.ws + OFF_UP); bf16* ACT = (bf16*)(F.ws + OFF_ACT);
    const int gt = F.vcu * (NWAVES * 64) + F.tid, NGT = F.G * NWAVES * 64;
    for (int item = gt; item < (M / 2) * (FF / 8); item += NGT) {
        const int lr = item / (FF / 8), cc = item % (FF / 8), ch = cc * 8, t = (rowbase + lr) % S;
        const int gcol = (ch >> 7) * 256 + (ch & 127);
        f32x4 g0 = *(const GAS f32x4*)(F.in[I_CFB] + ch), g1 = *(const GAS f32x4*)(F.in[I_CFB] + ch + 4), v0 = *(const GAS f32x4*)(F.in[I_CFB] + FF + ch), v1 = *(const GAS f32x4*)(F.in[I_CFB] + FF + ch + 4);
#pragma unroll
        for (int k = 0; k < 3; ++k) { const int tt = t + k - 1; if (tt >= 0 && tt < S) { const bf16* r = UP + (size_t)(lr + k - 1) * FF2 + gcol;
            const v4u xg = *(const GAS v4u*)r, xv = *(const GAS v4u*)(r + 128);
            const float* wg = F.in[I_CFW] + k * FF2 + ch; const float* wv = wg + FF;
            g0 += *(const GAS f32x4*)wg * (f32x4){bflo(xg.x), bfhi(xg.x), bflo(xg.y), bfhi(xg.y)}; g1 += *(const GAS f32x4*)(wg + 4) * (f32x4){bflo(xg.z), bfhi(xg.z), bflo(xg.w), bfhi(xg.w)};
            v0 += *(const GAS f32x4*)wv * (f32x4){bflo(xv.x), bfhi(xv.x), bflo(xv.y), bfhi(xv.y)}; v1 += *(const GAS f32x4*)(wv + 4) * (f32x4){bflo(xv.z), bfhi(xv.z), bflo(xv.w), bfhi(xv.w)}; } }
        float o[8];
#pragma unroll
        for (int j = 0; j < 8; ++j) { const float g = j < 4 ? g0[j] : g1[j - 4], v = j < 4 ? v0[j] : v1[j - 4];
            const float u2 = g * (1.5957691216057308f + 0.07135481627f * g * g);
            o[j] = g * __builtin_amdgcn_rcpf(1.0f + __builtin_amdgcn_exp2f(-LOG2E * u2)) * v; }
        v4u w; w.x = pk2(o[0], o[1]); w.y = pk2(o[2], o[3]); w.z = pk2(o[4], o[5]); w.w = pk2(o[6], o[7]);
        *(GAS v4u*)(ACT + (size_t)(rowbase + lr) * FF + ch) = w;
    }
}

__device__ __forceinline__ void final_phase(Frame& F) {
    const int gw = F.vcu * NWAVES + F.wave, NGW = F.G * NWAVES; const float* PS = (const float*)(F.ws + OFF_PS3);
    for (int m = gw; m < M; m += NGW) {
        const f32x4* ps = (const f32x4*)(PS + (size_t)m * 16); const f32x4 s4 = (ps[0] + ps[1]) + (ps[2] + ps[3]);
        const float rs = 1.0f / sqrtf(((s4[0] + s4[1]) + (s4[2] + s4[3])) * (1.0f / D) + EPS);
        GAS f32x4* xr = (GAS f32x4*)(F.out + (size_t)m * D) + F.lane; const GAS f32x4* gr = (const GAS f32x4*)F.in[I_GFINAL] + F.lane;
#pragma unroll
        for (int j = 0; j < 4; ++j) xr[64 * j] = xr[64 * j] * rs * gr[64 * j];
    }
}

struct Args { const float* in[N_IN]; float* out; unsigned char* ws; int ph_lo, ph_hi, li, pad; };
__global__ void __launch_bounds__(NWAVES * 64, 2) mk_fwd(Args args) {
    extern __shared__ __attribute__((aligned(16))) unsigned char lds[];
    Frame F;
    F.lds = (LAS unsigned char*)lds;
    F.MISC = (volatile LAS unsigned*)(F.lds + MISC_OFF);
    F.tid = threadIdx.x; F.lane = F.tid & 63; F.wave = __builtin_amdgcn_readfirstlane(F.tid >> 6);
    F.G = gridDim.x; { const int bx = blockIdx.x; F.vcu = (F.G % 8 == 0) ? (bx % 8) * (F.G / 8) + bx / 8 : bx; }
#pragma unroll
    for (int i = 0; i < N_IN; ++i) F.in[i] = args.in[i];
    F.out = args.out; F.ws = args.ws;
    F.ctl = (gu32*)(args.ws + WS_CTL);
    for (int u = F.tid; u < (LDS_BYTES - LDSCTL_OFF) / 4; u += NWAVES * 64) ((LAS unsigned*)(F.lds + LDSCTL_OFF))[u] = 0u;
    __syncthreads();
    XcdBarrier bar; bar.bar = (unsigned*)(F.ctl + CW_BAR); bar.x = 0; bar.st = nullptr;
    if (N_LAUNCHES == 1) bar = xcd_barrier_post((unsigned*)(F.ctl + CW_BAR), F.MISC + 8);
    const int lo = args.ph_lo, hi = args.ph_hi;
#define IN(k) (lo <= (k) && (k) < hi)
#define SEAM(k) do { if (IN(k) && IN((k) + 1)) xcd_barrier(bar); } while (0)
    unsigned char* ws = args.ws;
#ifndef SKIP0
    if (IN(0)) { p0_prologue(F); VM_WAIT(); __syncthreads(); }
#endif
    SEAM(0);
    if (IN(1)) {
        pg8::Gemm g{(const bf16*)(ws + OFF_XB), (const bf16*)(ws + OFF_WIN), M, INW, D}; pg8::StaticOrder So; So.init(M, INW, F.G, (int)blockIdx.x);
        pg8::EpiG1 E{0, (bf16*)(ws + OFF_UA), (bf16*)(ws + OFF_UB), (bf16*)(ws + OFF_RAT), (bf16*)(ws + OFF_GB), (const float*)(ws + OFF_RS1), args.in[I_BGATE]};
#ifndef SKIP1
        pg8::gemm_phase<pg8::EpiG1, pg8::StaticOrder, PG8_ALIGN, PG8_SP2>(F.lds + RING_OFF, g, So, E);
#endif
    } SEAM(1);
#ifndef SKIP2
    if (IN(2)) { scan_phase<false>(F); } SEAM(2);
#endif
#ifndef SKIP3
    if (IN(3)) { carry_pool_phase(F); } SEAM(3);
#endif
#ifndef SKIP4
    if (IN(4)) { scan_phase<true>(F); } SEAM(4);
#endif
    if (IN(5)) {
        pg8::Gemm g{(const bf16*)(ws + OFF_HP), (const bf16*)(ws + OFF_BT2), M, D, KM}; pg8::StaticOrder So; So.init(M, D, F.G, (int)blockIdx.x);
        pg8::EpiMerge E{LW / 64, (const bf16*)(ws + OFF_RAT), (const bf16*)(ws + OFF_GB), (const float*)(ws + OFF_BC), (bf16*)(ws + OFF_MG)};
#ifndef SKIP5
        pg8::gemm_phase<pg8::EpiMerge, pg8::StaticOrder, PG8_ALIGN, PG8_SP2>(F.lds + RING_OFF, g, So, E);
#endif
    } SEAM(5);
    if (IN(6)) {
        pg8::Gemm g{(const bf16*)(ws + OFF_MG), (const bf16*)(ws + OFF_WO), M, D, D}; pg8::StaticOrder So; So.init(M, D, F.G, (int)blockIdx.x);
        pg8::EpiRes<true> E{0, args.in[I_X], args.out, (bf16*)(ws + OFF_X1B), (float*)(ws + OFF_PS2)};
#ifndef SKIP6
        pg8::gemm_phase<pg8::EpiRes<true>, pg8::StaticOrder, PG8_ALIGN, PG8_SP2>(F.lds + RING_OFF, g, So, E);
#endif
    } SEAM(6);
#pragma unroll 1
    for (int h = 0; h < 2; ++h) {
        if (IN(7 + 2 * h)) {
            pg8::Gemm g{(const bf16*)(ws + OFF_X1B) + (size_t)h * (M / 2) * D, (const bf16*)(ws + OFF_WUP), M / 2, FF2, D}; pg8::StaticOrder So; So.init(M / 2, FF2, F.G, (int)blockIdx.x);
            pg8::EpiUp E{0, (const float*)(ws + OFF_PS2) + (size_t)h * (M / 2) * 16, (bf16*)(ws + OFF_UP), FF2};
#ifndef SKIP7
            pg8::gemm_phase<pg8::EpiUp, pg8::StaticOrder, PG8_ALIGN, PG8_SP2>(F.lds + RING_OFF, g, So, E);
#endif
        } SEAM(7 + 2 * h);
#ifndef SKIP8
        if (IN(8 + 2 * h)) { act_phase(F, h * (M / 2)); } SEAM(8 + 2 * h);
#endif
    }
    if (IN(11)) {
        pg8::Gemm g{(const bf16*)(ws + OFF_ACT), (const bf16*)(ws + OFF_WD), M, D, FF}; pg8::StaticOrder So; So.init(M, D, F.G, (int)blockIdx.x);
        pg8::EpiRes<false> E{0, args.out, args.out, nullptr, (float*)(ws + OFF_PS3)};
#ifndef SKIP11
        pg8::gemm_phase<pg8::EpiRes<false>, pg8::StaticOrder, PG8_ALIGN, PG8_SP2>(F.lds + RING_OFF, g, So, E);
#endif
    } SEAM(11);
#ifndef SKIP12
    if (IN(12)) { final_phase(F); }
#endif
#undef IN
#undef SEAM
}

extern "C" void kernel_launch(void* const* d_in, const int* in_sizes, int n_in, void* d_out, int out_size, void* d_ws, size_t ws_size, hipStream_t stream) {
    static int grid = 0;
    if (grid == 0) {
        if (n_in != N_IN || in_sizes[0] != M * D || out_size != M * D || ws_size < WS_NEED) { fprintf(stderr, "kernel_launch: unexpected shapes: n_in %d in0 %d out %d ws %zu; nothing launched\n", n_in, n_in > 0 ? in_sizes[0] : -1, out_size, ws_size); grid = -1; return; }
        int dev = 0, cus = 0, per_cu = 0;
        if (hipGetDevice(&dev) != hipSuccess || hipDeviceGetAttribute(&cus, hipDeviceAttributeMultiprocessorCount, dev) != hipSuccess) { grid = -1; return; }
        if (hipFuncSetAttribute((const void*)mk_fwd, hipFuncAttributeMaxDynamicSharedMemorySize, LDS_BYTES) != hipSuccess) { fprintf(stderr, "kernel_launch: hipFuncSetAttribute failed\n"); grid = -1; return; }
        if (hipOccupancyMaxActiveBlocksPerMultiprocessor(&per_cu, (const void*)mk_fwd, NWAVES * 64, LDS_BYTES) != hipSuccess || per_cu < 1) { fprintf(stderr, "kernel_launch: occupancy query says %d blocks per CU\n", per_cu); per_cu = 1; }
        (void)hipGetLastError();
        grid = cus;
    }
    if (grid < 0) return;
    if (hipMemsetAsync((char*)d_ws + WS_CTL, 0, CTL_ZERO_BYTES, stream) != hipSuccess) { fprintf(stderr, "kernel_launch: memset failed\n"); return; }
    Args a{};
    for (int i = 0; i < N_IN; ++i) a.in[i] = (const float*)d_in[i];
    a.out = (float*)d_out; a.ws = (unsigned char*)d_ws;
    if (N_LAUNCHES == 1) { a.ph_lo = 0; a.ph_hi = N_PHASES; a.li = 0; hipLaunchKernelGGL(mk_fwd, dim3(grid), dim3(NWAVES * 64), LDS_BYTES, stream, a); }
    else for (int li = 0; li < N_PHASES; ++li) { a.ph_lo = li; a.ph_hi = li + 1; a.li = li; hipLaunchKernelGGL(mk_fwd, dim3(grid), dim3(NWAVES * 64), LDS_BYTES, stream, a); }
    const hipError_t le = hipPeekAtLastError();
    if (le != hipSuccess) fprintf(stderr, "kernel_launch: launch failed: %s\n", hipGetErrorName(le));
}
```

```cpp
#include <hip/hip_runtime.h>
#include <cstdio>
#include <cstdint>

#ifndef MK_N_LAUNCHES
#define MK_N_LAUNCHES 1
#endif
namespace pg8 {
#define PG8_LAS __attribute__((address_space(3)))
typedef unsigned short bf16_t;
typedef short bf16x8 __attribute__((ext_vector_type(8)));
typedef float f32x4 __attribute__((ext_vector_type(4)));
typedef unsigned u32x4 __attribute__((ext_vector_type(4)));
constexpr int BM = 256, BK = 64, HALF = 128, HTB = HALF * BK * 2  , STAGE_BYTES = 8 * HTB, NXCD = 8, WGM = 8;

__host__ __device__ __forceinline__ int lds_byte(int r, int c) { const int st = (r >> 4) * 2 + (c >> 5), rr = r & 15, cc = c & 31, ob = rr * 64 + cc * 2; return st * 1024 + (ob ^ (((ob >> 9) & 1) << 5)); }
__host__ __device__ __forceinline__ void stage_rc(int b, int& R, int& C) { const int st = b / 1024, sb = b % 1024, swz = sb ^ (((sb >> 9) & 1) << 5); R = (st >> 1) * 16 + swz / 64; C = (st & 1) * 32 + (swz % 64) / 2; }
__host__ __device__ __forceinline__ int perm32(int rho) { const int n = rho >> 4, i = rho & 15; return 8 * (i >> 2) + 4 * n + (i & 3); }

struct Unit { int pm, pn; };
struct Gemm { const bf16_t* A; const bf16_t* Bt; int M, N, K; };

struct StaticOrder {
    int nM, nN, nwg, G, c;
    __host__ __device__ void init(int M, int N, int G_, int c_) { nM = M / BM; nN = N / BM; nwg = nM * nN; G = G_; c = c_; }
    __host__ __device__ bool next(int i, Unit& u) const {
        const long L = (long)i * G + c; if (L >= nwg) return false;
        int wgid = (int)L; { const int q = nwg / NXCD, r = nwg % NXCD, xcd = wgid % NXCD, off = wgid / NXCD; wgid = (xcd < r ? xcd * (q + 1) : r * (q + 1) + (xcd - r) * q) + off; }
        const int nig = WGM * nN, gid = wgid / nig, fm = gid * WGM, gsz = (nM - fm) < WGM ? (nM - fm) : WGM;
        u.pm = fm + ((wgid % nig) % gsz); u.pn = (wgid % nig) / gsz; return true;
    }
    __device__ __forceinline__ void a_ready(const Unit&) const {}
    __device__ __forceinline__ void done(const Unit&) const {}
};

__device__ __forceinline__ unsigned cvt_pk_bf16(float lo, float hi) { unsigned r; asm volatile("v_cvt_pk_bf16_f32 %0, %1, %2" : "=v"(r) : "v"(lo), "v"(hi)); return r; }
__device__ __forceinline__ float bflo(unsigned w) { return __uint_as_float(w << 16); }
__device__ __forceinline__ float bfhi(unsigned w) { return __uint_as_float(w & 0xffff0000u); }
typedef unsigned u32x2 __attribute__((ext_vector_type(2)));
constexpr float LOG2E = 1.4426950408889634f;

struct EpiG1 {
    static constexpr bool PERM = true, AFTER_DRAIN = false, HAS_MID = false; int tmid;
    bf16_t* UA; bf16_t* UB; bf16_t* RAT; bf16_t* GB; const float* rs1; const float* bgate;
    __device__ __forceinline__ void mid(f32x4 (&)[2][2][4][2], const Unit&, int, int, int, int) const {}
    __device__ __forceinline__ void operator()(const f32x4 (&acc)[2][2][4][2], const Unit& u, int wr, int wc, int fr, int fq) const {
        const int row0_ = u.pm * BM + wr * 64 + fr;
        int row0 = row0_; asm volatile("" : "+v"(row0));
        if (u.pn < 9) {
            bf16_t* base; int ldc, colt;
            if (u.pn < 5) { base = UA; ldc = 1280; colt = u.pn * 256; } else { base = UB; ldc = 1024; colt = (u.pn - 5) * 256; }
            const int col0 = colt + wc * 32 + 8 * fq;
#pragma unroll
            for (int ai = 0; ai < 2; ++ai)
#pragma unroll
                for (int m = 0; m < 4; ++m) { const int row = row0 + ai * HALF + m * 16; const float rs = rs1[row]; bf16_t* rowp = base + (size_t)row * ldc + col0;
#pragma unroll
                    for (int bj = 0; bj < 2; ++bj) { const f32x4 v0 = acc[ai][bj][m][0] * rs, v1 = acc[ai][bj][m][1] * rs;
                        u32x4 w; w.x = cvt_pk_bf16(v0[0], v0[1]); w.y = cvt_pk_bf16(v0[2], v0[3]); w.z = cvt_pk_bf16(v1[0], v1[1]); w.w = cvt_pk_bf16(v1[2], v1[3]);
                        *(u32x4*)(rowp + bj * HALF) = w; } }
        } else {
            const int ch0 = (u.pn - 9) * 128 + wc * 32 + 8 * fq;
            f32x4 ba[2], bb[2];
#pragma unroll
            for (int n = 0; n < 2; ++n) { ba[n] = *(const f32x4*)(bgate + ch0 + 4 * n) * (-LOG2E); bb[n] = *(const f32x4*)(bgate + 1024 + ch0 + 4 * n) * (-LOG2E); }
#pragma unroll
            for (int ai = 0; ai < 2; ++ai)
#pragma unroll
                for (int m = 0; m < 4; ++m) { const int row = row0 + ai * HALF + m * 16; const float rs = rs1[row] * (-LOG2E);
                    float ra[8], gb[8];
#pragma unroll
                    for (int n = 0; n < 2; ++n)
#pragma unroll
                        for (int j = 0; j < 4; ++j) { const float ea = __builtin_amdgcn_exp2f(acc[ai][0][m][n][j] * rs + ba[n][j]); const float eb = fminf(__builtin_amdgcn_exp2f(acc[ai][1][m][n][j] * rs + bb[n][j]), 1e18f);
                            gb[4 * n + j] = __builtin_amdgcn_rcpf(1.0f + eb); ra[4 * n + j] = (1.0f + eb) * __builtin_amdgcn_rcpf(1.0f + ea); }
                    u32x4 w; w.x = cvt_pk_bf16(ra[0], ra[1]); w.y = cvt_pk_bf16(ra[2], ra[3]); w.z = cvt_pk_bf16(ra[4], ra[5]); w.w = cvt_pk_bf16(ra[6], ra[7]);
                    *(u32x4*)((char*)RAT + ((unsigned)row * 1024u + (unsigned)ch0) * 2u) = w;
                    w.x = cvt_pk_bf16(gb[0], gb[1]); w.y = cvt_pk_bf16(gb[2], gb[3]); w.z = cvt_pk_bf16(gb[4], gb[5]); w.w = cvt_pk_bf16(gb[6], gb[7]);
                    *(u32x4*)((char*)GB + ((unsigned)row * 1024u + (unsigned)ch0) * 2u) = w; }
        }
    }
};

struct EpiMerge {
    static constexpr bool PERM = true, AFTER_DRAIN = false, HAS_MID = true; int tmid;
    const bf16_t* RAT; const bf16_t* GB; const float* bc; bf16_t* MG;
    __device__ __forceinline__ void mid(f32x4 (&acc)[2][2][4][2], const Unit& u, int wr, int wc, int fr, int fq) const {
        const int row0_ = u.pm * BM + wr * 64 + fr, col0 = u.pn * BM + wc * 32 + 8 * fq;
        int row0 = row0_; asm volatile("" : "+v"(row0));
#pragma unroll
        for (int ai = 0; ai < 2; ++ai)
#pragma unroll
            for (int m = 0; m < 4; ++m) { const unsigned rb = ((unsigned)(row0 + ai * HALF + m * 16) * 1024u + (unsigned)col0) * 2u;
#pragma unroll
                for (int bj = 0; bj < 2; ++bj) { const u32x4 w = *(const u32x4*)((const char*)RAT + (rb + bj * HALF * 2u));
                    acc[ai][bj][m][0] *= (f32x4){bflo(w.x), bfhi(w.x), bflo(w.y), bfhi(w.y)}; acc[ai][bj][m][1] *= (f32x4){bflo(w.z), bfhi(w.z), bflo(w.w), bfhi(w.w)}; }
                asm volatile("" ::: "memory"); }
    }
    __device__ __forceinline__ void operator()(const f32x4 (&acc)[2][2][4][2], const Unit& u, int wr, int wc, int fr, int fq) const {
        const int row0_ = u.pm * BM + wr * 64 + fr, col0 = u.pn * BM + wc * 32 + 8 * fq;
        int row0 = row0_; asm volatile("" : "+v"(row0));
        f32x4 bv[2][2];
#pragma unroll
        for (int bj = 0; bj < 2; ++bj)
#pragma unroll
            for (int n = 0; n < 2; ++n) bv[bj][n] = *(const f32x4*)(bc + col0 + bj * HALF + 4 * n);
#pragma unroll
        for (int ai = 0; ai < 2; ++ai)
#pragma unroll
            for (int m = 0; m < 4; ++m) { const unsigned rb = ((unsigned)(row0 + ai * HALF + m * 16) * 1024u + (unsigned)col0) * 2u;
#pragma unroll
                for (int bj = 0; bj < 2; ++bj) { const u32x4 g = *(const u32x4*)((const char*)GB + (rb + bj * HALF * 2u));
                    const f32x4 v0 = (acc[ai][bj][m][0] + bv[bj][0]) * (f32x4){bflo(g.x), bfhi(g.x), bflo(g.y), bfhi(g.y)}, v1 = (acc[ai][bj][m][1] + bv[bj][1]) * (f32x4){bflo(g.z), bfhi(g.z), bflo(g.w), bfhi(g.w)};
                    u32x4 w; w.x = cvt_pk_bf16(v0[0], v0[1]); w.y = cvt_pk_bf16(v0[2], v0[3]); w.z = cvt_pk_bf16(v1[0], v1[1]); w.w = cvt_pk_bf16(v1[2], v1[3]);
                    *(u32x4*)((char*)MG + (rb + bj * HALF * 2u)) = w; }
                asm volatile("" ::: "memory"); }
    }
};

template <bool WRITE_BF> struct EpiRes {
    static constexpr bool PERM = false, AFTER_DRAIN = false, HAS_MID = false; int tmid;
    const float* xin; float* out; bf16_t* XB; float* PS;
    __device__ __forceinline__ void mid(f32x4 (&)[2][2][4][2], const Unit&, int, int, int, int) const {}
    __device__ __forceinline__ void operator()(const f32x4 (&acc)[2][2][4][2], const Unit& u, int wr, int wc, int fr, int fq) const {
        const int row0_ = u.pm * BM + wr * 64 + fr, col0 = u.pn * BM + wc * 32 + 4 * fq;
        int row0 = row0_; asm volatile("" : "+v"(row0));
#pragma unroll
        for (int ai = 0; ai < 2; ++ai)
#pragma unroll
            for (int m = 0; m < 4; ++m) { const int row = row0 + ai * HALF + m * 16; const unsigned off = (unsigned)row * 1024u + (unsigned)col0; float ss = 0.f;
#pragma unroll
                for (int bj = 0; bj < 2; ++bj)
#pragma unroll
                    for (int n = 0; n < 2; ++n) { const unsigned o = off + bj * HALF + n * 16; const f32x4 x1 = *(const f32x4*)((const char*)xin + o * 4u) + acc[ai][bj][m][n]; *(f32x4*)((char*)out + o * 4u) = x1;
                        ss += (x1[0] * x1[0] + x1[1] * x1[1]) + (x1[2] * x1[2] + x1[3] * x1[3]);
                        if (WRITE_BF) { u32x2 w; w.x = cvt_pk_bf16(x1[0], x1[1]); w.y = cvt_pk_bf16(x1[2], x1[3]); *(u32x2*)((char*)XB + o * 2u) = w; } }
                ss += __shfl_xor(ss, 16); ss += __shfl_xor(ss, 32);
                if (fq == 0) PS[(size_t)row * 16 + u.pn * 4 + wc] = ss; }
    }
};

struct EpiUp {
    static constexpr bool PERM = true, AFTER_DRAIN = false, HAS_MID = false; int tmid;
    const float* PS; bf16_t* UP; int ldc;
    __device__ __forceinline__ void mid(f32x4 (&)[2][2][4][2], const Unit&, int, int, int, int) const {}
    __device__ __forceinline__ void operator()(const f32x4 (&acc)[2][2][4][2], const Unit& u, int wr, int wc, int fr, int fq) const {
        const int row0_ = u.pm * BM + wr * 64 + fr, col0 = u.pn * BM + wc * 32 + 8 * fq;
        int row0 = row0_; asm volatile("" : "+v"(row0));
#pragma unroll
        for (int ai = 0; ai < 2; ++ai)
#pragma unroll
            for (int m = 0; m < 4; ++m) { const int row = row0 + ai * HALF + m * 16; const f32x4* ps = (const f32x4*)(PS + (size_t)row * 16);
                const f32x4 s4 = (ps[0] + ps[1]) + (ps[2] + ps[3]); const float rs = 1.0f / sqrtf(((s4[0] + s4[1]) + (s4[2] + s4[3])) * (1.0f / 1024.0f) + 1e-6f);
                bf16_t* rowp = UP + (size_t)row * ldc + col0;
#pragma unroll
                for (int bj = 0; bj < 2; ++bj) { const f32x4 v0 = acc[ai][bj][m][0] * rs, v1 = acc[ai][bj][m][1] * rs;
                    u32x4 w; w.x = cvt_pk_bf16(v0[0], v0[1]); w.y = cvt_pk_bf16(v0[2], v0[3]); w.z = cvt_pk_bf16(v1[0], v1[1]); w.w = cvt_pk_bf16(v1[2], v1[3]);
                    *(u32x4*)(rowp + bj * HALF) = w; } }
    }
};
template <class Epi, class Sched, bool ALIGN_EPI = false, bool SP2 = false>
__device__ __forceinline__ void gemm_phase(PG8_LAS unsigned char* lds, const Gemm g, const Sched& S, const Epi& E) {
    const int tid = threadIdx.x, wid = __builtin_amdgcn_readfirstlane(tid >> 6), lane = tid & 63, wr = wid >> 2, wc = wid & 3, fr = lane & 15, fq = lane >> 4;
    const int K = g.K, nt = K / BK;
    unsigned voffA[2], voffB[2];
#pragma unroll
    for (int i = 0; i < 2; ++i) { int R, C; stage_rc(tid * 16 + i * 8192, R, C); const int Rb = Epi::PERM ? ((R & ~31) + perm32(R & 31)) : R;
        voffA[i] = (unsigned)(R * K + C) * 2u; voffB[i] = (unsigned)(Rb * K + C) * 2u; }
    const size_t kstep = (size_t)(BK * 2);
    const size_t hstep = (size_t)HALF * K * 2;
    const size_t tstep = 2 * hstep;
    const unsigned ldsw = (unsigned)wid * 1024u;
    const int aoff = lds_byte(wr * 64 + fr, fq * 8), boff = lds_byte(wc * 32 + fr, fq * 8);
#define PG8_SA(b, h) (((b) * 2 + (h)) * HTB)
#define PG8_SB(b, h) ((4 + (b) * 2 + (h)) * HTB)
#define PG8_STAGE(bufoff, gbase, voff) do { _Pragma("unroll") for (int _i = 0; _i < 2; ++_i) \
        __builtin_amdgcn_global_load_lds((const unsigned*)((const char*)(gbase) + (voff)[_i]), (PG8_LAS unsigned*)(lds + (bufoff) + ldsw + _i * 8192), 16, 0, 0); } while (0)
#define PG8_LDA(dst, b, h) do { _Pragma("unroll") for (int m = 0; m < 4; ++m) _Pragma("unroll") for (int k = 0; k < 2; ++k) dst[m][k] = *(const PG8_LAS bf16x8*)(lds + PG8_SA(b, h) + aoff + m * 2048 + k * 1024); } while (0)
#define PG8_LDB(dst, b, h) do { _Pragma("unroll") for (int n = 0; n < 2; ++n) _Pragma("unroll") for (int k = 0; k < 2; ++k) dst[n][k] = *(const PG8_LAS bf16x8*)(lds + PG8_SB(b, h) + boff + n * 2048 + k * 1024); } while (0)
#define PG8_MMA(ai, bj, At, Bt) do { __builtin_amdgcn_s_setprio(1); _Pragma("unroll") for (int m = 0; m < 4; ++m) _Pragma("unroll") for (int n = 0; n < 2; ++n) _Pragma("unroll") for (int k = 0; k < 2; ++k) \
        acc[ai][bj][m][n] = __builtin_amdgcn_mfma_f32_16x16x32_bf16(Bt[n][k], At[m][k], acc[ai][bj][m][n], 0, 0, 0); __builtin_amdgcn_s_setprio(0); } while (0)
#define PG8_WAIT_V(n) asm volatile("s_waitcnt vmcnt(" #n ")" ::: "memory")
#define PG8_WAIT_L(n) asm volatile("s_waitcnt lgkmcnt(" #n ")" ::: "memory")
#define PG8_BAR __builtin_amdgcn_s_barrier()
#define PG8_SCHED __builtin_amdgcn_sched_barrier(0)
    Unit cur, nxt; int ui = 0;
    if (!S.next(0, cur)) return;
    f32x4 acc[2][2][4][2];
#pragma unroll
    for (int a = 0; a < 2; ++a)
#pragma unroll
        for (int b = 0; b < 2; ++b)
#pragma unroll
            for (int m = 0; m < 4; ++m)
#pragma unroll
                for (int n = 0; n < 2; ++n) acc[a][b][m][n] = (f32x4){0.f, 0.f, 0.f, 0.f};
    bf16x8 At[4][2], B0[2][2], B1[2][2];
    const char* cA = (const char*)g.A + (size_t)cur.pm * tstep; const char* cB = (const char*)g.Bt + (size_t)cur.pn * tstep;
    S.a_ready(cur);
    if constexpr (SP2) {
        PG8_STAGE(PG8_SB(0, 0), cB, voffB); PG8_STAGE(PG8_SB(0, 1), cB + hstep, voffB); PG8_STAGE(PG8_SA(0, 0), cA, voffA); PG8_STAGE(PG8_SA(0, 1), cA + hstep, voffA);
        if (wr == 1) PG8_BAR;
        PG8_WAIT_V(2); PG8_BAR;
        PG8_STAGE(PG8_SB(1, 0), cB + kstep, voffB); PG8_STAGE(PG8_SA(1, 0), cA + kstep, voffA); PG8_STAGE(PG8_SB(1, 1), cB + hstep + kstep, voffB);
        PG8_WAIT_V(6); PG8_BAR;
    } else {
        PG8_STAGE(PG8_SB(0, 0), cB, voffB); PG8_STAGE(PG8_SA(0, 0), cA, voffA); PG8_STAGE(PG8_SB(0, 1), cB + hstep, voffB); PG8_STAGE(PG8_SA(0, 1), cA + hstep, voffA);
        if (wr == 1) PG8_BAR;
        PG8_WAIT_V(4); PG8_BAR;
        PG8_STAGE(PG8_SB(1, 0), cB + kstep, voffB); PG8_STAGE(PG8_SA(1, 0), cA + kstep, voffA); PG8_STAGE(PG8_SB(1, 1), cB + hstep + kstep, voffB);
        PG8_WAIT_V(6); PG8_BAR;
    }
    for (;;) {
        const bool has_next = S.next(ui + 1, nxt);
        const char* nA = has_next ? (const char*)g.A + (size_t)nxt.pm * tstep : cA; const char* nB = has_next ? (const char*)g.Bt + (size_t)nxt.pn * tstep : cB;
#pragma unroll 1
        for (int part = 0; part < (Epi::HAS_MID ? 2 : 1); ++part) {
        const int tb_ = (Epi::HAS_MID && part == 1) ? E.tmid : 0, te_ = (Epi::HAS_MID && part == 0) ? E.tmid : nt;
#pragma unroll 1
        for (int t = tb_; t < te_; t += 2) {
            const bool last = (t == nt - 2);
            const char* a1 = cA + (size_t)(t + 1) * kstep;
            const char* a2 = last ? nA : cA + (size_t)(t + 2) * kstep; const char* b2 = last ? nB : cB + (size_t)(t + 2) * kstep;
            const char* a3 = a2 + kstep; const char* b3 = b2 + kstep;
            if (last && has_next) S.a_ready(nxt);
            if constexpr (SP2) {
            PG8_LDB(B0, 0, 0); PG8_LDB(B1, 0, 1); PG8_SCHED; PG8_LDA(At, 0, 0); PG8_STAGE(PG8_SA(1, 1), a1 + hstep, voffA);
            PG8_WAIT_V(8); PG8_WAIT_L(0); PG8_BAR; PG8_MMA(0, 0, At, B0); PG8_MMA(0, 1, At, B1); PG8_BAR; PG8_SCHED;
            PG8_LDA(At, 0, 1); PG8_STAGE(PG8_SB(0, 0), b2, voffB); PG8_STAGE(PG8_SB(0, 1), b2 + hstep, voffB); PG8_STAGE(PG8_SA(0, 0), a2, voffA);
            PG8_WAIT_V(8); PG8_WAIT_L(0); PG8_BAR; PG8_MMA(1, 0, At, B0); PG8_MMA(1, 1, At, B1); PG8_BAR; PG8_SCHED;
            PG8_LDB(B0, 1, 0); PG8_LDB(B1, 1, 1); PG8_SCHED; PG8_LDA(At, 1, 0); PG8_STAGE(PG8_SA(0, 1), a2 + hstep, voffA);
            PG8_WAIT_V(8); PG8_WAIT_L(0); PG8_BAR; PG8_MMA(0, 0, At, B0); PG8_MMA(0, 1, At, B1); PG8_BAR; PG8_SCHED;
            PG8_LDA(At, 1, 1); PG8_STAGE(PG8_SB(1, 0), b3, voffB); PG8_STAGE(PG8_SB(1, 1), b3 + hstep, voffB); PG8_STAGE(PG8_SA(1, 0), a3, voffA);
            PG8_WAIT_V(8); PG8_WAIT_L(0); PG8_BAR; PG8_MMA(1, 0, At, B0); PG8_MMA(1, 1, At, B1); PG8_BAR; PG8_SCHED;
            } else {
            PG8_LDB(B0, 0, 0); PG8_SCHED; PG8_LDA(At, 0, 0); PG8_STAGE(PG8_SA(1, 1), a1 + hstep, voffA);
            PG8_WAIT_L(8); PG8_BAR; PG8_WAIT_L(0); PG8_MMA(0, 0, At, B0); PG8_BAR; PG8_SCHED;
            PG8_LDB(B1, 0, 1); PG8_STAGE(PG8_SB(0, 0), b2, voffB);
            PG8_BAR; PG8_WAIT_L(0); PG8_MMA(0, 1, At, B1); PG8_BAR;
            PG8_LDA(At, 0, 1); PG8_STAGE(PG8_SA(0, 0), a2, voffA);
            PG8_BAR; PG8_WAIT_L(0); PG8_MMA(1, 0, At, B0); PG8_BAR; PG8_SCHED;
            PG8_STAGE(PG8_SB(0, 1), b2 + hstep, voffB);
            PG8_WAIT_V(6); PG8_BAR; PG8_MMA(1, 1, At, B1); PG8_BAR;
            PG8_LDB(B0, 1, 0); PG8_SCHED; PG8_LDA(At, 1, 0); PG8_STAGE(PG8_SA(0, 1), a2 + hstep, voffA);
            PG8_WAIT_L(8); PG8_BAR; PG8_WAIT_L(0); PG8_MMA(0, 0, At, B0); PG8_BAR; PG8_SCHED;
            PG8_LDB(B1, 1, 1); PG8_STAGE(PG8_SB(1, 0), b3, voffB);
            PG8_BAR; PG8_WAIT_L(0); PG8_MMA(0, 1, At, B1); PG8_BAR;
            PG8_LDA(At, 1, 1); PG8_STAGE(PG8_SA(1, 0), a3, voffA);
            PG8_BAR; PG8_WAIT_L(0); PG8_MMA(1, 0, At, B0); PG8_BAR; PG8_SCHED;
            PG8_STAGE(PG8_SB(1, 1), b3 + hstep, voffB);
            PG8_WAIT_V(6); PG8_BAR; PG8_MMA(1, 1, At, B1); PG8_BAR;
            }
        }
        if constexpr (Epi::HAS_MID) { if (part == 0) E.mid(acc, cur, wr, wc, fr, fq); }
        }
        if constexpr (ALIGN_EPI) { if (wr == 0) PG8_BAR; }
        if constexpr (!Epi::AFTER_DRAIN) { E(acc, cur, wr, wc, fr, fq); S.done(cur); }
        if (!has_next) break;
#pragma unroll
        for (int a = 0; a < 2; ++a)
#pragma unroll
            for (int b = 0; b < 2; ++b)
#pragma unroll
                for (int m = 0; m < 4; ++m)
#pragma unroll
                    for (int n = 0; n < 2; ++n) acc[a][b][m][n] = (f32x4){0.f, 0.f, 0.f, 0.f};
        cur = nxt; cA = nA; cB = nB; ++ui;
        if constexpr (ALIGN_EPI) { if (wr == 1) PG8_BAR; }
    }
    PG8_WAIT_V(0);
    if constexpr (!ALIGN_EPI) { if (wr == 0) PG8_BAR; }
    PG8_BAR;
    if constexpr (Epi::AFTER_DRAIN) { E.fused(acc, cur, wr, wc, fr, fq, lds, wid, lane); S.done(cur); }
#undef PG8_SA
#undef PG8_SB
#undef PG8_STAGE
#undef PG8_LDA
#undef PG8_LDB
#undef PG8_MMA
#undef PG8_WAIT_V
#undef PG8_WAIT_L
#undef PG8_BAR
#undef PG8_SCHED
}
}
#ifndef PG8_SP2
#define PG8_SP2 true
#endif
#ifndef PG8_ALIGN
#define PG8_ALIGN true
#endif
constexpr int NWAVES = 8;
constexpr int N_LAUNCHES = MK_N_LAUNCHES;
constexpr int N_PHASES = 13;
constexpr int NB = 4, S = 8192, D = 1024, M = NB * S;
constexpr int LW = 1280, NH = 10, HD = 128, PW = 1024, INW = 4352, FF = 2816, FF2 = 5632, KM = LW + PW  ;
constexpr float EPS = 1e-6f;
constexpr int SEG = 16, NSEG = S / SEG;
constexpr int TC = 256, NCHUNK = S / TC;
constexpr size_t MiB = 1u << 20;
constexpr size_t WS_CTL = 0, CTL_ZERO_BYTES = 64 * 1024;
constexpr size_t OFF_WIN = 1 * MiB;
constexpr size_t OFF_WUP = 10 * MiB;
constexpr size_t OFF_WD = 21 * MiB;
constexpr size_t OFF_BT2 = 27 * MiB;
constexpr size_t OFF_WO = 32 * MiB;
constexpr size_t OFF_WG = 34 * MiB;
constexpr size_t OFF_RS1 = 36 * MiB;
constexpr size_t OFF_BC = OFF_RS1 + 128 * 1024;
constexpr size_t OFF_LAMC = OFF_BC + 4096;
constexpr size_t OFF_PS2 = 38 * MiB;
constexpr size_t OFF_PS3 = 40 * MiB;
constexpr size_t OFF_UA = 48 * MiB;
constexpr size_t OFF_X1B = 48 * MiB;
constexpr size_t OFF_UB = 128 * MiB;
constexpr size_t OFF_MG = 128 * MiB;
constexpr size_t OFF_RAT = 192 * MiB;
constexpr size_t OFF_GB = 256 * MiB;
constexpr size_t OFF_HP = 320 * MiB;
constexpr size_t OFF_XB = 448 * MiB;
constexpr size_t OFF_UP = 112 * MiB;
constexpr size_t OFF_ACT = 288 * MiB;
constexpr size_t WS_NEED = 512 * MiB;
constexpr size_t DO_CAR = 0, DO_HIN = 40 * MiB;
constexpr int CW_TMO = 0, CW_BAR = 4096;
constexpr int RING_OFF = 0, RING_BYTES = 131072;
constexpr int LDSCTL_OFF = RING_BYTES, MISC_OFF = LDSCTL_OFF + 320;
constexpr int LDS_BYTES = 147456;
enum { I_X = 0, I_GMIX, I_WIN, I_BGATE, I_CAW, I_CAB, I_WAF, I_BAF, I_WXF, I_BXF, I_LAMF, I_WAB, I_BAB, I_WXB, I_BXB, I_LAMB,
       I_WPOOL, I_BPOOL, I_PSCALE, I_PA, I_PB, I_WOUT, I_GFFN, I_WUP, I_CFW, I_CFB, I_WDOWN, I_GFINAL, N_IN };

#define GAS __attribute__((address_space(1)))
#define LAS __attribute__((address_space(3)))
typedef unsigned short bf16;
typedef unsigned v4u __attribute__((ext_vector_type(4)));
typedef float f32x4 __attribute__((ext_vector_type(4)));
typedef float f32x2 __attribute__((ext_vector_type(2)));
typedef float f32x16 __attribute__((ext_vector_type(16)));
typedef short bf16x8 __attribute__((ext_vector_type(8)));
typedef GAS unsigned gu32;
#define RLX_AGENT __ATOMIC_RELAXED, __HIP_MEMORY_SCOPE_AGENT
#define LDS_WAIT() asm volatile("s_waitcnt lgkmcnt(0)" ::: "memory")
#define VM_WAIT() asm volatile("s_waitcnt vmcnt(0)" ::: "memory")
__device__ __forceinline__ unsigned f2bf(float f) { unsigned u = __builtin_bit_cast(unsigned, f); return (u + 0x7fffu + ((u >> 16) & 1u)) >> 16; }
__device__ __forceinline__ unsigned pk2(float lo, float hi) { return f2bf(lo) | (f2bf(hi) << 16); }
__device__ __forceinline__ float bflo(unsigned w) { return __uint_as_float(w << 16); }
__device__ __forceinline__ float bfhi(unsigned w) { return __uint_as_float(w & 0xffff0000u); }
constexpr float LOG2E = 1.4426950408889634f;
#define XB_TMO      128
#define XB_XCNT(j)  (256  + 64 * (j))
#define XB_XSUB(j)  (1280 + 64 * (j))
#define XB_XGEN(j)  (2304 + 64 * (j))
#define XB_TOP      3328
#define XB_TOPGEN   3392
#define XCD_BAR_WORDS 3456
#define XB_SPIN_CAP (1u << 18)

__device__ __forceinline__ unsigned xb_ld(unsigned* p)              { return __hip_atomic_load(p, __ATOMIC_RELAXED, __HIP_MEMORY_SCOPE_AGENT); }
__device__ __forceinline__ unsigned xb_add(unsigned* p, unsigned v) { return __hip_atomic_fetch_add(p, v, __ATOMIC_RELAXED, __HIP_MEMORY_SCOPE_AGENT); }
__device__ __forceinline__ unsigned xb_xcc_id() { return (unsigned)__builtin_amdgcn_s_getreg((3 << 11) | 20) & 0xFu; }
#define XB_SPIN(cond, bar) do { unsigned _sp = 0; while (cond) { __builtin_amdgcn_s_sleep(1); \
    if ((++_sp & 255u) == 0u) { if (xb_ld(&(bar)[XB_TMO])) break; if (_sp > XB_SPIN_CAP) { atomicAdd(&(bar)[XB_TMO], 1u); break; } } } } while (0)

struct XcdBarrier {
    unsigned* bar; unsigned x;
    volatile LAS unsigned* st;
};

__device__ __forceinline__ XcdBarrier xcd_barrier_post(unsigned* bar, volatile LAS unsigned* st) {
    XcdBarrier b; b.bar = bar; b.x = xb_xcc_id(); b.st = st;
    if (threadIdx.x == 0) (void)xb_add(&bar[XB_XCNT(b.x)], 1u);
    return b;
}
__device__ __forceinline__ void xcd_barrier_complete(unsigned* bar, unsigned x, unsigned& nloc, unsigned& nx) {
    const unsigned G = gridDim.x * gridDim.y * gridDim.z;
    unsigned sum, cnt, mine, sp = 0u;
    for (;;) {
        sum = 0u; cnt = 0u; mine = 0u;
#pragma unroll
        for (unsigned j = 0; j < 16; ++j) { const unsigned c = xb_ld(&bar[XB_XCNT(j)]); sum += c; cnt += (c > 0u) ? 1u : 0u; mine = (j == x) ? c : mine; }
        if (sum == G) break;
        __builtin_amdgcn_s_sleep(1);
        if ((++sp & 255u) == 0u) { if (xb_ld(&bar[XB_TMO])) break; if (sp > XB_SPIN_CAP) { atomicAdd(&bar[XB_TMO], 1u); break; } }
    }
    nloc = mine > 0u ? mine : 1u; nx = cnt > 0u ? cnt : 1u;
}

__device__ __forceinline__ void xcd_barrier(const XcdBarrier& b) {
    asm volatile("s_waitcnt vmcnt(0)" ::: "memory");
    __syncthreads();
    if (threadIdx.x == 0) {
        unsigned* bar = b.bar;
        __builtin_amdgcn_s_waitcnt(0);
        unsigned nloc = b.st[0], nx = b.st[1];
        if (nloc == 0u) { xcd_barrier_complete(bar, b.x, nloc, nx); b.st[0] = nloc; b.st[1] = nx; }
        const unsigned old = xb_add(&bar[XB_XSUB(b.x)], 1u);
        const unsigned gen = old / nloc;
        if (old + 1u == (gen + 1u) * nloc) {
            __builtin_amdgcn_fence(__ATOMIC_RELEASE, "agent");
            asm volatile("s_waitcnt vmcnt(0)" ::: "memory");
            const unsigned og = xb_add(&bar[XB_TOP], 1u);
            const unsigned tg = og / nx;
            if (og + 1u == (tg + 1u) * nx) xb_add(&bar[XB_TOPGEN], 1u);
            else XB_SPIN(xb_ld(&bar[XB_TOPGEN]) == tg, bar);
            __builtin_amdgcn_fence(__ATOMIC_ACQUIRE, "agent");
            xb_add(&bar[XB_XGEN(b.x)], 1u);
            asm volatile("s_waitcnt vmcnt(0)" ::: "memory");
        } else {
            XB_SPIN(xb_ld(&bar[XB_XGEN(b.x)]) == gen, bar);
            __builtin_amdgcn_fence(__ATOMIC_ACQUIRE, "agent");
            asm volatile("s_waitcnt vmcnt(0)" ::: "memory");
        }
    }
    __syncthreads();
}
struct Frame {
    LAS unsigned char* lds;
    volatile LAS unsigned* MISC;
    gu32* ctl;
    int tid, lane, wave;
    int vcu, G;
    const float* in[N_IN];
    float* out; unsigned char* ws;
};
__device__ __forceinline__ float wave_sum(float v) {
#pragma unroll
    for (int o = 1; o < 64; o <<= 1) v += __shfl_xor(v, o);
    return v;
}

__device__ __forceinline__ void p0_transpose_item(const float* W, int N, const float* kscale, bf16* dst_row0  , int ldk, int k0, int n0, int swz, LAS float* scr, int lane) {
#pragma unroll 8
    for (int i = 0; i < 32; ++i) { const int kk = 2 * i + (lane >> 5); float v = W[(size_t)(k0 + kk) * N + n0 + (lane & 31)]; if (kscale) v *= kscale[k0 + kk]; scr[kk * 33 + (lane & 31)] = v; }
    LDS_WAIT(); asm volatile("" ::: "memory");
    const int c = lane & 7;
#pragma unroll
    for (int j = 0; j < 4; ++j) { const int n = (lane >> 3) + 8 * j; const LAS float* s = scr + (8 * c) * 33 + n;
        v4u o; o.x = pk2(s[0 * 33], s[1 * 33]); o.y = pk2(s[2 * 33], s[3 * 33]); o.z = pk2(s[4 * 33], s[5 * 33]); o.w = pk2(s[6 * 33], s[7 * 33]);
        int chunk = (k0 >> 3) + c; if (swz) chunk ^= (n0 + n) & 15;
        *(GAS v4u*)(dst_row0 + (size_t)n * ldk + chunk * 8) = o; }
    LDS_WAIT(); asm volatile("" ::: "memory");
}
__device__ __forceinline__ void p0_prologue(Frame& F) {
    LAS float* scr = (LAS float*)(F.lds + RING_OFF + F.wave * 16384);
    const int gw = F.vcu * NWAVES + F.wave, NGW = F.G * NWAVES;
    bf16* WinT = (bf16*)(F.ws + OFF_WIN); bf16* WupT = (bf16*)(F.ws + OFF_WUP); bf16* WdT = (bf16*)(F.ws + OFF_WD); bf16* BT2 = (bf16*)(F.ws + OFF_BT2);
    bf16* WoT = (bf16*)(F.ws + OFF_WO); bf16* WgT = (bf16*)(F.ws + OFF_WG);
    constexpr int I_IN = (D / 64) * (INW / 32), I_UP = (D / 64) * (FF2 / 32), I_DN = (FF / 64) * (D / 32), I_PAI = (LW / 64) * (D / 32), I_WOI = (D / 64) * (D / 32), I_G = NH * 4 * 2 * 4;
    constexpr int NITEMS = I_IN + I_UP + I_DN + I_PAI + I_WOI + I_G;
    for (int it = gw; it < NITEMS; it += NGW) {
        int r = it;
        if (r < I_IN) { const int nblk = INW / 32, kb = r / nblk, n0 = (r % nblk) * 32; int drow = n0;
            if (n0 >= LW + PW) { const int c2 = n0 - (LW + PW), bj = c2 >> 10, ch = c2 & 1023; drow = LW + PW + 256 * (ch >> 7) + 128 * bj + (ch & 127); }
            p0_transpose_item(F.in[I_WIN], INW, F.in[I_GMIX], WinT + (size_t)drow * D, D, 64 * kb, n0, 0, scr, F.lane); continue; } r -= I_IN;
        if (r < I_UP) { const int nblk = FF2 / 32, kb = r / nblk, n0 = (r % nblk) * 32; const int bj = n0 / FF, ch = n0 % FF; const int drow = 256 * (ch >> 7) + 128 * bj + (ch & 127);
            p0_transpose_item(F.in[I_WUP], FF2, F.in[I_GFFN], WupT + (size_t)drow * D, D, 64 * kb, n0, 0, scr, F.lane); continue; } r -= I_UP;
        if (r < I_DN) { const int nblk = D / 32, kb = r / nblk, n0 = (r % nblk) * 32;
            p0_transpose_item(F.in[I_WDOWN], D, nullptr, WdT + (size_t)n0 * FF, FF, 64 * kb, n0, 0, scr, F.lane); continue; } r -= I_DN;
        if (r < I_PAI) { const int nblk = D / 32, kb = r / nblk, n0 = (r % nblk) * 32;
            p0_transpose_item(F.in[I_PA], D, nullptr, BT2 + (size_t)n0 * KM, KM, 64 * kb, n0, 0, scr, F.lane); continue; } r -= I_PAI;
        if (r < I_WOI) { const int nblk = D / 32, kb = r / nblk, n0 = (r % nblk) * 32;
            p0_transpose_item(F.in[I_WOUT], D, nullptr, WoT + (size_t)n0 * D, D, 64 * kb, n0, 0, scr, F.lane); continue; } r -= I_WOI;
        {
            const int hd = r / 32, g = (r >> 3) & 3, kb = (r >> 2) & 1, n0 = (r & 3) * 32;
            const float* src = (g == 0 ? F.in[I_WAF] : g == 1 ? F.in[I_WXF] : g == 2 ? F.in[I_WAB] : F.in[I_WXB]) + (size_t)hd * HD * HD;
            p0_transpose_item(src, HD, nullptr, WgT + ((size_t)hd * 512 + g * 128 + n0) * HD, HD, 64 * kb, n0, 1, scr, F.lane); }
    }
    float* rs1 = (float*)(F.ws + OFF_RS1); bf16* XB = (bf16*)(F.ws + OFF_XB);
    for (int m0 = gw * 4; m0 < M; m0 += NGW * 4) {
        f32x4 v[4][4];
#pragma unroll
        for (int r = 0; r < 4; ++r) { const GAS f32x4* xr = (const GAS f32x4*)(F.in[I_X] + (size_t)(m0 + r) * D) + F.lane;
#pragma unroll
            for (int j = 0; j < 4; ++j) v[r][j] = xr[64 * j]; }
#pragma unroll
        for (int r = 0; r < 4; ++r) { float s = 0.f;
#pragma unroll
            for (int j = 0; j < 4; ++j) s += (v[r][j].x * v[r][j].x + v[r][j].y * v[r][j].y) + (v[r][j].z * v[r][j].z + v[r][j].w * v[r][j].w);
            s = wave_sum(s);
            if (F.lane == 0) rs1[m0 + r] = 1.0f / sqrtf(s * (1.0f / D) + EPS);
            GAS unsigned long long* o8 = (GAS unsigned long long*)(XB + (size_t)(m0 + r) * D) + F.lane;
#pragma unroll
            for (int j = 0; j < 4; ++j) o8[64 * j] = (unsigned long long)pk2(v[r][j].x, v[r][j].y) | ((unsigned long long)pk2(v[r][j].z, v[r][j].w) << 32); }
    }
    if (F.tid < 2 * LW / 8 && F.vcu == F.G - 1) { for (int i = F.tid; i < 2 * LW; i += 2 * LW / 8) { const float lam = (i < LW ? F.in[I_LAMF] : F.in[I_LAMB])[i % LW]; ((float*)(F.ws + OFF_LAMC))[i] = -8.0f * LOG2E * log1pf(expf(-lam)); } }
    __syncthreads();
    for (int T = F.vcu; T < 256; T += F.G) {
        const int k0 = (T >> 2) * 16, g = k0 >> 8, kk0 = k0 & 255, n0 = (T & 3) * 256;
        const float* wp = F.in[I_WPOOL] + (size_t)g * 65536 + kk0 * 256; const float* sc = F.in[I_PSCALE] + g * 256; const float* pb = F.in[I_PB] + (size_t)(g * 256) * D + n0 + 4 * F.lane;
        f32x4 acc[16];
#pragma unroll
        for (int i = 0; i < 16; ++i) acc[i] = (f32x4){0.f, 0.f, 0.f, 0.f};
#pragma unroll 4
        for (int jj = 0; jj < 32; ++jj) { const int j = 32 * F.wave + jj; const f32x4 pv = *(const GAS f32x4*)(pb + (size_t)j * D) * sc[j];
#pragma unroll
            for (int i = 0; i < 16; ++i) acc[i] += pv * wp[i * 256 + j]; }
        LAS f32x4* red = (LAS f32x4*)(F.lds + RING_OFF);
#pragma unroll
        for (int i = 0; i < 16; ++i) red[(F.wave * 16 + i) * 64 + F.lane] = acc[i];
        LDS_WAIT(); __builtin_amdgcn_s_barrier(); asm volatile("" ::: "memory");
        { const int nl = F.tid & 255, kh = F.tid >> 8; float o[8];
#pragma unroll
            for (int i = 0; i < 8; ++i) { float sm = 0.f;
#pragma unroll
                for (int v = 0; v < 8; ++v) sm += ((const LAS float*)(red + (v * 16 + 8 * kh + i) * 64 + (nl >> 2)))[nl & 3];
                o[i] = sm; }
            v4u w; w.x = pk2(o[0], o[1]); w.y = pk2(o[2], o[3]); w.z = pk2(o[4], o[5]); w.w = pk2(o[6], o[7]);
            *(GAS v4u*)(BT2 + (size_t)(n0 + nl) * KM + LW + k0 + 8 * kh) = w; }
        LDS_WAIT(); __builtin_amdgcn_s_barrier(); asm volatile("" ::: "memory");
    }
    for (int T = F.vcu; T < 16; T += F.G) {
        const float* pb = F.in[I_PB] + T * 64 + F.lane; float sm = 0.f;
#pragma unroll 16
        for (int cc = 0; cc < 128; ++cc) { const int c = 128 * F.wave + cc; sm += F.in[I_BPOOL][c] * F.in[I_PSCALE][c] * pb[(size_t)c * D]; }
        LAS float* red = (LAS float*)(F.lds + RING_OFF);
        red[F.wave * 64 + F.lane] = sm;
        LDS_WAIT(); __builtin_amdgcn_s_barrier(); asm volatile("" ::: "memory");
        if (F.tid < 64) { float t = 0.f;
#pragma unroll
            for (int v = 0; v < 8; ++v) t += red[v * 64 + F.tid];
            ((float*)(F.ws + OFF_BC))[T * 64 + F.tid] = t; }
        LDS_WAIT(); __builtin_amdgcn_s_barrier(); asm volatile("" ::: "memory");
    }
}

template <bool FINAL>
__device__ __forceinline__ void scan_phase(Frame& F) {
    const int tid = F.tid, lane = F.lane, w = F.wave, c31 = lane & 31, hi = lane >> 5;
    LAS unsigned char* xat = F.lds + RING_OFF;
    LAS unsigned char* bbuf = F.lds + RING_OFF + 65536;
    const bf16* UA = (const bf16*)(F.ws + OFF_UA); const unsigned char* WgT = F.ws + OFF_WG; const float* lamc = (const float*)(F.ws + OFF_LAMC);
    f32x2* CAR = (f32x2*)((unsigned char*)F.out + DO_CAR); const float* HIN = (const float*)((unsigned char*)F.out + DO_HIN); bf16* HP = (bf16*)(F.ws + OFF_HP);
    const int NITEM = NB * NCHUNK * NH;
    const int tau = (c31 & 3) + 4 * (c31 >> 3) + 16 * ((c31 >> 2) & 1);
    const int arow = 32 * w + tau;
    const unsigned ldsw = (unsigned)w * 1024u;
#define SC_BGLDS(hd_, q_, buf_) do { _Pragma("unroll") for (int i_ = 0; i_ < 4; ++i_) { const int p_ = tid + 512 * i_, nl_ = p_ >> 4, ch_ = p_ & 15; const int ng_ = (nl_ >> 5) * 128 + 32 * (q_) + (nl_ & 31); \
        __builtin_amdgcn_global_load_lds((const unsigned*)(WgT + ((size_t)(hd_) * 512 + ng_) * 256 + ch_ * 16), (LAS unsigned*)(bbuf + (buf_) * 32768 + i_ * 8192 + ldsw), 16, 0, 0); } } while (0)
    int cur = 0; bool first = true;
    for (int it = F.vcu; it < NITEM; it += F.G) {
        const int hd = it % NH, bc_ = it / NH, b = bc_ / NCHUNK, t0 = (bc_ % NCHUNK) * TC;
        if (first) { SC_BGLDS(hd, 0, 0); cur = 0; first = false; }
        {
            const int cc = tid & 15, tg = tid >> 4;
            const int chg = hd * HD + 8 * cc;
            f32x4 wv[4][2], cb[2];
#pragma unroll
            for (int k = 0; k < 4; ++k) { wv[k][0] = *(const GAS f32x4*)(F.in[I_CAW] + k * LW + chg); wv[k][1] = *(const GAS f32x4*)(F.in[I_CAW] + k * LW + chg + 4); }
            cb[0] = *(const GAS f32x4*)(F.in[I_CAB] + chg); cb[1] = *(const GAS f32x4*)(F.in[I_CAB] + chg + 4);
            v4u u[11];
#pragma unroll
            for (int i = 0; i < 11; ++i) { const int t = t0 + 8 * tg - 2 + i; u[i] = (v4u){0u, 0u, 0u, 0u};
                if (t >= 0 && t < S) u[i] = *(const GAS v4u*)(UA + ((size_t)b * S + t) * LW + chg); }
#pragma unroll
            for (int tt = 0; tt < 8; ++tt) { f32x4 a0 = cb[0], a1 = cb[1];
#pragma unroll
                for (int k = 0; k < 4; ++k) { const v4u x = u[tt + k];
                    a0 += wv[k][0] * (f32x4){bflo(x.x), bfhi(x.x), bflo(x.y), bfhi(x.y)}; a1 += wv[k][1] * (f32x4){bflo(x.z), bfhi(x.z), bflo(x.w), bfhi(x.w)}; }
                const int row = 8 * tg + tt; v4u o; o.x = pk2(a0[0], a0[1]); o.y = pk2(a0[2], a0[3]); o.z = pk2(a1[0], a1[1]); o.w = pk2(a1[2], a1[3]);
                *(LAS v4u*)(xat + row * 256 + ((cc ^ (row & 15)) << 4)) = o; }
        }
        VM_WAIT(); LDS_WAIT(); __builtin_amdgcn_s_barrier(); asm volatile("" ::: "memory");
        bf16x8 af[8];
#pragma unroll
        for (int ks = 0; ks < 8; ++ks) af[ks] = *(const LAS bf16x8*)(xat + arow * 256 + (((2 * ks + hi) ^ (arow & 15)) << 4));
#pragma unroll 1
        for (int q = 0; q < 4; ++q) {
            { const int itn = it + F.G; if (q < 3) SC_BGLDS(hd, q + 1, cur ^ 1); else if (itn < NITEM) SC_BGLDS(itn % NH, 0, cur ^ 1); }
            const int cl = 32 * q + c31, cg = hd * HD + cl, seg = (t0 + 32 * w + 16 * hi) / SEG;
            float xa[16];
#pragma unroll
            for (int r = 0; r < 16; ++r) { const int row = 32 * w + 16 * hi + r; xa[r] = __uint_as_float((unsigned)(*(const LAS unsigned short*)(xat + row * 256 + (((cl >> 3) ^ r) << 4) + (cl & 7) * 2)) << 16); }
            float hsum[16];
#pragma unroll
            for (int dir = 0; dir < 2; ++dir) {
                f32x16 ga, gx;
#pragma unroll
                for (int r = 0; r < 16; ++r) { ga[r] = 0.f; gx[r] = 0.f; }
#pragma unroll
                for (int ks = 0; ks < 8; ++ks) { const int na = 32 * (2 * dir) + c31, nx = na + 32;
                    const bf16x8 ba_ = *(const LAS bf16x8*)(bbuf + cur * 32768 + na * 256 + (((2 * ks + hi) ^ (na & 15)) << 4));
                    const bf16x8 bx_ = *(const LAS bf16x8*)(bbuf + cur * 32768 + nx * 256 + (((2 * ks + hi) ^ (nx & 15)) << 4));
                    ga = __builtin_amdgcn_mfma_f32_32x32x16_bf16(af[ks], ba_, ga, 0, 0, 0); gx = __builtin_amdgcn_mfma_f32_32x32x16_bf16(af[ks], bx_, gx, 0, 0, 0); }
                const float nba = -LOG2E * (dir ? F.in[I_BAB] : F.in[I_BAF])[cg], nbx = -LOG2E * (dir ? F.in[I_BXB] : F.in[I_BXF])[cg], lc2 = lamc[dir * LW + cg];
                float av[16], bv[16];
#pragma unroll
                for (int r = 0; r < 16; ++r) {
                    const float er = __builtin_amdgcn_exp2f(ga[r] * (-LOG2E) + nba), rg = __builtin_amdgcn_rcpf(1.0f + er);
                    const float a = __builtin_amdgcn_exp2f(lc2 * rg);
                    const float ei = __builtin_amdgcn_exp2f(gx[r] * (-LOG2E) + nbx), ig = __builtin_amdgcn_rcpf(1.0f + ei);
                    av[r] = a; bv[r] = __builtin_amdgcn_sqrtf(fmaxf(1.0f - a * a, 0.f)) * (ig * xa[r]); }
                if (!FINAL) {
                    float A = 1.f, Bv = 0.f;
#pragma unroll
                    for (int i = 0; i < 16; ++i) { const int r = dir ? 15 - i : i; Bv = av[r] * Bv + bv[r]; A *= av[r]; }
                    CAR[(((size_t)dir * NB + b) * NSEG + seg) * LW + cg] = (f32x2){A, Bv};
                } else {
                    float h = HIN[(((size_t)dir * NB + b) * NSEG + seg) * LW + cg];
#pragma unroll
                    for (int i = 0; i < 16; ++i) { const int r = dir ? 15 - i : i; h = av[r] * h + bv[r]; if (dir == 0) hsum[r] = h; else hsum[r] += h; }
                }
            }
            if (FINAL) {
#pragma unroll
                for (int r = 0; r < 16; ++r) { const int row = 32 * w + 16 * hi + r; *(LAS unsigned short*)(xat + row * 256 + (((cl >> 3) ^ r) << 4) + (cl & 7) * 2) = (unsigned short)f2bf(hsum[r]); }
            }
            VM_WAIT(); LDS_WAIT(); __builtin_amdgcn_s_barrier(); asm volatile("" ::: "memory");
            cur ^= 1;
        }
        if (FINAL) {
#pragma unroll
            for (int i = 0; i < 8; ++i) { const int p = tid + 512 * i, row = p >> 4, chs = p & 15; const v4u v = *(const LAS v4u*)(xat + row * 256 + (chs << 4));
                *(GAS v4u*)(HP + ((size_t)b * S + t0 + row) * KM + hd * HD + ((chs ^ (row & 15)) << 3)) = v; }
            LDS_WAIT(); __builtin_amdgcn_s_barrier(); asm volatile("" ::: "memory");
        }
    }
#undef SC_BGLDS
}

template <int HW>
__device__ __forceinline__ void pool_item(const bf16* ub, bf16* hp, int t0) {
    constexpr int NR = 16 + 2 * HW - 1;
    v4u u[NR];
#pragma unroll
    for (int i = 0; i < NR; ++i) { const int t = t0 - HW + i; u[i] = (v4u){0u, 0u, 0u, 0u}; if (t >= 0 && t < S) u[i] = *(const GAS v4u*)(ub + (size_t)t * PW); }
    float sum[8];
#pragma unroll
    for (int j = 0; j < 8; ++j) sum[j] = 0.f;
#define PL_ACC(x_, sgn_) do { sum[0] += (sgn_) * bflo((x_).x); sum[1] += (sgn_) * bfhi((x_).x); sum[2] += (sgn_) * bflo((x_).y); sum[3] += (sgn_) * bfhi((x_).y); \
        sum[4] += (sgn_) * bflo((x_).z); sum[5] += (sgn_) * bfhi((x_).z); sum[6] += (sgn_) * bflo((x_).w); sum[7] += (sgn_) * bfhi((x_).w); } while (0)
#pragma unroll
    for (int i = 0; i < 2 * HW; ++i) PL_ACC(u[i], 1.f);
#pragma unroll
    for (int i = 0; i < 16; ++i) { const int t = t0 + i;
        const int lo = max(t - HW, 0), hi = min(t + HW - 1, S - 1); const float inv = 1.0f / (float)(hi - lo + 1);
        const v4u x = u[i + HW];
        v4u o; o.x = pk2(sum[0] * inv - bflo(x.x), sum[1] * inv - bfhi(x.x)); o.y = pk2(sum[2] * inv - bflo(x.y), sum[3] * inv - bfhi(x.y));
        o.z = pk2(sum[4] * inv - bflo(x.z), sum[5] * inv - bfhi(x.z)); o.w = pk2(sum[6] * inv - bflo(x.w), sum[7] * inv - bfhi(x.w));
        *(GAS v4u*)(hp + (size_t)t * KM) = o;
        if (i < 15) { PL_ACC(u[i + 2 * HW], 1.f); PL_ACC(u[i], -1.f); } }
#undef PL_ACC
}
__device__ __forceinline__ void carry_pool_phase(Frame& F) {
    {
        const f32x2* CAR = (const f32x2*)((unsigned char*)F.out + DO_CAR); float* HIN = (float*)((unsigned char*)F.out + DO_HIN);
        LAS f32x2* sh = (LAS f32x2*)(F.lds + RING_OFF);
        for (int task = F.vcu; task < 2 * NB * (LW / 64); task += F.G) {
            const int cgp = task % (LW / 64), db = task / (LW / 64), dir = db / NB, ss = F.tid >> 6, c = cgp * 64 + F.lane;
            const size_t base = (size_t)db * NSEG * LW + c;
            const long sstep = dir ? -(long)LW : (long)LW; const f32x2* cp = CAR + base + (size_t)(dir ? (NSEG - 1 - ss * 64) : ss * 64) * LW;
            float A = 1.f, Bv = 0.f;
#pragma unroll 16
            for (int i = 0; i < 64; ++i) { const f32x2 ab = cp[(long)i * sstep]; Bv = ab.x * Bv + ab.y; A *= ab.x; }
            sh[ss * 64 + F.lane] = (f32x2){A, Bv};
            LDS_WAIT(); __builtin_amdgcn_s_barrier(); asm volatile("" ::: "memory");
            float h = 0.f;
            for (int s2 = 0; s2 < ss; ++s2) { const f32x2 t = sh[s2 * 64 + F.lane]; h = t.x * h + t.y; }
            float* hp = HIN + base + (size_t)(dir ? (NSEG - 1 - ss * 64) : ss * 64) * LW;
#pragma unroll 16
            for (int i = 0; i < 64; ++i) { const f32x2 ab = cp[(long)i * sstep]; hp[(long)i * sstep] = h; h = ab.x * h + ab.y; }
            LDS_WAIT(); __builtin_amdgcn_s_barrier(); asm volatile("" ::: "memory");
        }
    }
    {
        const int gt = F.vcu * (NWAVES * 64) + F.tid, NGT = F.G * NWAVES * 64;
        for (int item = gt; item < (M / 16) * (PW / 8); item += NGT) {
            const int g = (item >> 6) & 3, cc = g * 32 + (item & 31), tb = ((item >> 8) << 1) | ((item >> 5) & 1), b = tb / (S / 16), t0 = (tb % (S / 16)) * 16;
            const bf16* ub = (const bf16*)(F.ws + OFF_UB) + (size_t)b * S * PW + cc * 8; bf16* hp = (bf16*)(F.ws + OFF_HP) + (size_t)b * S * KM + LW + cc * 8;
            if (g == 0) pool_item<1>(ub, hp, t0); else if (g == 1) pool_item<2>(ub, hp, t0); else if (g == 2) pool_item<4>(ub, hp, t0); else pool_item<8>(ub, hp, t0);
        }
    }
}

__device__ __forceinline__ void act_phase(Frame& F, int rowbase) {
    const bf16* UP = (const bf16*)(F.ws + OFF_UP); bf16* ACT = (bf16*)(F.ws + OFF_ACT);
    const int gt = F.vcu * (NWAVES * 64) + F.tid, NGT = F.G * NWAVES * 64;
    for (int item = gt; item < (M / 2) * (FF / 8); item += NGT) {
        const int lr = item / (FF / 8), cc = item % (FF / 8), ch = cc * 8, t = (rowbase + lr) % S;
        const int gcol = (ch >> 7) * 256 + (ch & 127);
        f32x4 g0 = *(const GAS f32x4*)(F.in[I_CFB] + ch), g1 = *(const GAS f32x4*)(F.in[I_CFB] + ch + 4), v0 = *(const GAS f32x4*)(F.in[I_CFB] + FF + ch), v1 = *(const GAS f32x4*)(F.in[I_CFB] + FF + ch + 4);
#pragma unroll
        for (int k = 0; k < 3; ++k) { const int tt = t + k - 1; if (tt >= 0 && tt < S) { const bf16* r = UP + (size_t)(lr + k - 1) * FF2 + gcol;
            const v4u xg = *(const GAS v4u*)r, xv = *(const GAS v4u*)(r + 128);
            const float* wg = F.in[I_CFW] + k * FF2 + ch; const float* wv = wg + FF;
            g0 += *(const GAS f32x4*)wg * (f32x4){bflo(xg.x), bfhi(xg.x), bflo(xg.y), bfhi(xg.y)}; g1 += *(const GAS f32x4*)(wg + 4) * (f32x4){bflo(xg.z), bfhi(xg.z), bflo(xg.w), bfhi(xg.w)};
            v0 += *(const GAS f32x4*)wv * (f32x4){bflo(xv.x), bfhi(xv.x), bflo(xv.y), bfhi(xv.y)}; v1 += *(const GAS f32x4*)(wv + 4) * (f32x4){bflo(xv.z), bfhi(xv.z), bflo(xv.w), bfhi(xv.w)}; } }
        float o[8];
#pragma unroll
        for (int j = 0; j < 8; ++j) { const float g = j < 4 ? g0[j] : g1[j - 4], v = j < 4 ? v0[j] : v1[j - 4];
            const float u2 = g * (1.5957691216057308f + 0.07135481627f * g * g);
            o[j] = g * __builtin_amdgcn_rcpf(1.0f + __builtin_amdgcn_exp2f(-LOG2E * u2)) * v; }
        v4u w; w.x = pk2(o[0], o[1]); w.y = pk2(o[2], o[3]); w.z = pk2(o[4], o[5]); w.w = pk2(o[6], o[7]);
        *(GAS v4u*)(ACT + (size_t)(rowbase + lr) * FF + ch) = w;
    }
}

__device__ __forceinline__ void final_phase(Frame& F) {
    const int gw = F.vcu * NWAVES + F.wave, NGW = F.G * NWAVES; const float* PS = (const float*)(F.ws + OFF_PS3);
    f32x4 gv[4];
#pragma unroll
    for (int j = 0; j < 4; ++j) gv[j] = ((const GAS f32x4*)F.in[I_GFINAL])[F.lane + 64 * j];
    for (int m0 = gw * 4; m0 < M; m0 += NGW * 4) {
        f32x4 v[4][4], ps[4][4];
#pragma unroll
        for (int r = 0; r < 4; ++r) { const GAS f32x4* xr = (const GAS f32x4*)(F.out + (size_t)(m0 + r) * D) + F.lane; const GAS f32x4* pr = (const GAS f32x4*)(PS + (size_t)(m0 + r) * 16);
#pragma unroll
            for (int j = 0; j < 4; ++j) { v[r][j] = xr[64 * j]; ps[r][j] = pr[j]; } }
#pragma unroll
        for (int r = 0; r < 4; ++r) { const f32x4 s4 = (ps[r][0] + ps[r][1]) + (ps[r][2] + ps[r][3]);
            const float rs = 1.0f / sqrtf(((s4[0] + s4[1]) + (s4[2] + s4[3])) * (1.0f / D) + EPS);
            GAS f32x4* xw = (GAS f32x4*)(F.out + (size_t)(m0 + r) * D) + F.lane;
#pragma unroll
            for (int j = 0; j < 4; ++j) xw[64 * j] = v[r][j] * rs * gv[j]; }
    }
}

struct Args { const float* in[N_IN]; float* out; unsigned char* ws; int ph_lo, ph_hi, li, pad; };
__global__ void __launch_bounds__(NWAVES * 64, 2) mk_fwd(Args args) {
    extern __shared__ __attribute__((aligned(16))) unsigned char lds[];
    Frame F;
    F.lds = (LAS unsigned char*)lds;
    F.MISC = (volatile LAS unsigned*)(F.lds + MISC_OFF);
    F.tid = threadIdx.x; F.lane = F.tid & 63; F.wave = __builtin_amdgcn_readfirstlane(F.tid >> 6);
    F.G = gridDim.x; { const int bx = blockIdx.x; F.vcu = (F.G % 8 == 0) ? (bx % 8) * (F.G / 8) + bx / 8 : bx; }
#pragma unroll
    for (int i = 0; i < N_IN; ++i) F.in[i] = args.in[i];
    F.out = args.out; F.ws = args.ws;
    F.ctl = (gu32*)(args.ws + WS_CTL);
    for (int u = F.tid; u < (LDS_BYTES - LDSCTL_OFF) / 4; u += NWAVES * 64) ((LAS unsigned*)(F.lds + LDSCTL_OFF))[u] = 0u;
    __syncthreads();
    XcdBarrier bar; bar.bar = (unsigned*)(F.ctl + CW_BAR); bar.x = 0; bar.st = nullptr;
    if (N_LAUNCHES == 1) bar = xcd_barrier_post((unsigned*)(F.ctl + CW_BAR), F.MISC + 8);
    const int lo = args.ph_lo, hi = args.ph_hi;
#define IN(k) (lo <= (k) && (k) < hi)
#define SEAM(k) do { if (IN(k) && IN((k) + 1)) xcd_barrier(bar); } while (0)
    unsigned char* ws = args.ws;
#ifndef SKIP0
    if (IN(0)) { p0_prologue(F); VM_WAIT(); __syncthreads(); }
#endif
    SEAM(0);
    if (IN(1)) {

        pg8::Gemm g{(const bf16*)(ws + OFF_XB), (const bf16*)(ws + OFF_WIN), M, INW, D}; pg8::StaticOrder So; So.init(M, INW, F.G, (int)blockIdx.x);
        pg8::EpiG1 E{0, (bf16*)(ws + OFF_UA), (bf16*)(ws + OFF_UB), (bf16*)(ws + OFF_RAT), (bf16*)(ws + OFF_GB), (const float*)(ws + OFF_RS1), args.in[I_BGATE]};
#ifndef SKIP1
        pg8::gemm_phase<pg8::EpiG1, pg8::StaticOrder, PG8_ALIGN, PG8_SP2>(F.lds + RING_OFF, g, So, E);
#endif
    } SEAM(1);
#ifndef SKIP2
    if (IN(2)) { scan_phase<false>(F); } SEAM(2);
#endif
#ifndef SKIP3
    if (IN(3)) { carry_pool_phase(F); } SEAM(3);
#endif
#ifndef SKIP4
    if (IN(4)) { scan_phase<true>(F); } SEAM(4);
#endif
    if (IN(5)) {

        pg8::Gemm g{(const bf16*)(ws + OFF_HP), (const bf16*)(ws + OFF_BT2), M, D, KM}; pg8::StaticOrder So; So.init(M, D, F.G, (int)blockIdx.x);
        pg8::EpiMerge E{LW / 64, (const bf16*)(ws + OFF_RAT), (const bf16*)(ws + OFF_GB), (const float*)(ws + OFF_BC), (bf16*)(ws + OFF_MG)};
#ifndef SKIP5
        pg8::gemm_phase<pg8::EpiMerge, pg8::StaticOrder, PG8_ALIGN, PG8_SP2>(F.lds + RING_OFF, g, So, E);
#endif
    } SEAM(5);
    if (IN(6)) {

        pg8::Gemm g{(const bf16*)(ws + OFF_MG), (const bf16*)(ws + OFF_WO), M, D, D}; pg8::StaticOrder So; So.init(M, D, F.G, (int)blockIdx.x);
        pg8::EpiRes<true> E{0, args.in[I_X], args.out, (bf16*)(ws + OFF_X1B), (float*)(ws + OFF_PS2)};
#ifndef SKIP6
        pg8::gemm_phase<pg8::EpiRes<true>, pg8::StaticOrder, PG8_ALIGN, PG8_SP2>(F.lds + RING_OFF, g, So, E);
#endif
    } SEAM(6);
#pragma unroll 1
    for (int h = 0; h < 2; ++h) {
        if (IN(7 + 2 * h)) {

            pg8::Gemm g{(const bf16*)(ws + OFF_X1B) + (size_t)h * (M / 2) * D, (const bf16*)(ws + OFF_WUP), M / 2, FF2, D}; pg8::StaticOrder So; So.init(M / 2, FF2, F.G, (int)blockIdx.x);
            pg8::EpiUp E{0, (const float*)(ws + OFF_PS2) + (size_t)h * (M / 2) * 16, (bf16*)(ws + OFF_UP), FF2};
#ifndef SKIP7
            pg8::gemm_phase<pg8::EpiUp, pg8::StaticOrder, PG8_ALIGN, PG8_SP2>(F.lds + RING_OFF, g, So, E);
#endif
        } SEAM(7 + 2 * h);
#ifndef SKIP8
        if (IN(8 + 2 * h)) { act_phase(F, h * (M / 2)); } SEAM(8 + 2 * h);
#endif
    }
    if (IN(11)) {

        pg8::Gemm g{(const bf16*)(ws + OFF_ACT), (const bf16*)(ws + OFF_WD), M, D, FF}; pg8::StaticOrder So; So.init(M, D, F.G, (int)blockIdx.x);
        pg8::EpiRes<false> E{0, args.out, args.pad ? (float*)(ws + OFF_UP) : args.out, nullptr, (float*)(ws + OFF_PS3)};
#ifndef SKIP11
        pg8::gemm_phase<pg8::EpiRes<false>, pg8::StaticOrder, PG8_ALIGN, PG8_SP2>(F.lds + RING_OFF, g, So, E);
#endif
    } SEAM(11);
#ifndef SKIP12
    if (IN(12)) { final_phase(F); }
#endif
#undef IN
#undef SEAM
}

extern "C" void kernel_launch(void* const* d_in, const int* in_sizes, int n_in, void* d_out, int out_size, void* d_ws, size_t ws_size, hipStream_t stream) {
    static int grid = 0;
    if (grid == 0) {
        if (n_in != N_IN || in_sizes[0] != M * D || out_size != M * D || ws_size < WS_NEED) { fprintf(stderr, "kernel_launch: unexpected shapes: n_in %d in0 %d out %d ws %zu; nothing launched\n", n_in, n_in > 0 ? in_sizes[0] : -1, out_size, ws_size); grid = -1; return; }
        int dev = 0, cus = 0, per_cu = 0;
        if (hipGetDevice(&dev) != hipSuccess || hipDeviceGetAttribute(&cus, hipDeviceAttributeMultiprocessorCount, dev) != hipSuccess) { grid = -1; return; }
        if (hipFuncSetAttribute((const void*)mk_fwd, hipFuncAttributeMaxDynamicSharedMemorySize, LDS_BYTES) != hipSuccess) { fprintf(stderr, "kernel_launch: hipFuncSetAttribute failed\n"); grid = -1; return; }
        if (hipOccupancyMaxActiveBlocksPerMultiprocessor(&per_cu, (const void*)mk_fwd, NWAVES * 64, LDS_BYTES) != hipSuccess || per_cu < 1) { fprintf(stderr, "kernel_launch: occupancy query says %d blocks per CU\n", per_cu); per_cu = 1; }
        (void)hipGetLastError();
        grid = cus;
    }
    if (grid < 0) return;
    if (hipMemsetAsync((char*)d_ws + WS_CTL, 0, CTL_ZERO_BYTES, stream) != hipSuccess) { fprintf(stderr, "kernel_launch: memset failed\n"); return; }
    Args a{};
    for (int i = 0; i < N_IN; ++i) a.in[i] = (const float*)d_in[i];
    a.out = (float*)d_out; a.ws = (unsigned char*)d_ws;
    if (N_LAUNCHES == 1) { a.ph_lo = 0; a.ph_hi = N_PHASES; a.li = 0; hipLaunchKernelGGL(mk_fwd, dim3(grid), dim3(NWAVES * 64), LDS_BYTES, stream, a); }
    else for (int li = 0; li < N_PHASES; ++li) { a.ph_lo = li; a.ph_hi = li + 1; a.li = li;
#ifdef PROBE_DUP
        if ((PROBE_DUP >> li) & 1) { a.pad = (li == 11); hipLaunchKernelGGL(mk_fwd, dim3(grid), dim3(NWAVES * 64), LDS_BYTES, stream, a); a.pad = 0; }
#endif
        hipLaunchKernelGGL(mk_fwd, dim3(grid), dim3(NWAVES * 64), LDS_BYTES, stream, a); }
    const hipError_t le = hipPeekAtLastError();
    if (le != hipSuccess) fprintf(stderr, "kernel_launch: launch failed: %s\n", hipGetErrorName(le));
}
```

```cpp
#include <hip/hip_runtime.h>
#include <cstdio>
#include <cstdint>

#ifndef MK_N_LAUNCHES
#define MK_N_LAUNCHES 1
#endif
namespace pg8 {
#define PG8_LAS __attribute__((address_space(3)))
typedef unsigned short bf16_t;
typedef short bf16x8 __attribute__((ext_vector_type(8)));
typedef float f32x4 __attribute__((ext_vector_type(4)));
typedef unsigned u32x4 __attribute__((ext_vector_type(4)));
constexpr int BM = 256, BK = 64, HALF = 128, HTB = HALF * BK * 2  , STAGE_BYTES = 8 * HTB, NXCD = 8, WGM = 8;

__host__ __device__ __forceinline__ int lds_byte(int r, int c) { const int st = (r >> 4) * 2 + (c >> 5), rr = r & 15, cc = c & 31, ob = rr * 64 + cc * 2; return st * 1024 + (ob ^ (((ob >> 9) & 1) << 5)); }
__host__ __device__ __forceinline__ void stage_rc(int b, int& R, int& C) { const int st = b / 1024, sb = b % 1024, swz = sb ^ (((sb >> 9) & 1) << 5); R = (st >> 1) * 16 + swz / 64; C = (st & 1) * 32 + (swz % 64) / 2; }
__host__ __device__ __forceinline__ int perm32(int rho) { const int n = rho >> 4, i = rho & 15; return 8 * (i >> 2) + 4 * n + (i & 3); }

struct Unit { int pm, pn; };
struct Gemm { const bf16_t* A; const bf16_t* Bt; int M, N, K; };

struct StaticOrder {
    int nM, nN, nwg, G, c;
    __host__ __device__ void init(int M, int N, int G_, int c_) { nM = M / BM; nN = N / BM; nwg = nM * nN; G = G_; c = c_; }
    __host__ __device__ bool next(int i, Unit& u) const {
        const long L = (long)i * G + c; if (L >= nwg) return false;
        int wgid = (int)L; { const int q = nwg / NXCD, r = nwg % NXCD, xcd = wgid % NXCD, off = wgid / NXCD; wgid = (xcd < r ? xcd * (q + 1) : r * (q + 1) + (xcd - r) * q) + off; }
        const int nig = WGM * nN, gid = wgid / nig, fm = gid * WGM, gsz = (nM - fm) < WGM ? (nM - fm) : WGM;
        u.pm = fm + ((wgid % nig) % gsz); u.pn = (wgid % nig) / gsz; return true;
    }
    __device__ __forceinline__ void a_ready(const Unit&) const {}
    __device__ __forceinline__ void done(const Unit&) const {}
};

__device__ __forceinline__ unsigned cvt_pk_bf16(float lo, float hi) { unsigned r; asm volatile("v_cvt_pk_bf16_f32 %0, %1, %2" : "=v"(r) : "v"(lo), "v"(hi)); return r; }
__device__ __forceinline__ float bflo(unsigned w) { return __uint_as_float(w << 16); }
__device__ __forceinline__ float bfhi(unsigned w) { return __uint_as_float(w & 0xffff0000u); }
typedef unsigned u32x2 __attribute__((ext_vector_type(2)));
constexpr float LOG2E = 1.4426950408889634f;

struct EpiG1 {
    static constexpr bool PERM = true, AFTER_DRAIN = false, HAS_MID = false, INIT_ACC = false; int tmid;
    bf16_t* UA; bf16_t* UB; bf16_t* RAT; bf16_t* GB; const float* rs1; const float* bgate;
    __device__ __forceinline__ void mid(f32x4 (&)[2][2][4][2], const Unit&, int, int, int, int) const {}
    __device__ __forceinline__ void operator()(const f32x4 (&acc)[2][2][4][2], const Unit& u, int wr, int wc, int fr, int fq) const {
        const int row0_ = u.pm * BM + wr * 64 + fr;
        int row0 = row0_; asm volatile("" : "+v"(row0));
        if (u.pn < 9) {
            bf16_t* base; int ldc, colt;
            if (u.pn < 5) { base = UA; ldc = 1280; colt = u.pn * 256; } else { base = UB; ldc = 1024; colt = (u.pn - 5) * 256; }
            const int col0 = colt + wc * 32 + 8 * fq;
#pragma unroll
            for (int ai = 0; ai < 2; ++ai)
#pragma unroll
                for (int m = 0; m < 4; ++m) { const int row = row0 + ai * HALF + m * 16; const float rs = rs1[row]; bf16_t* rowp = base + (size_t)row * ldc + col0;
#pragma unroll
                    for (int bj = 0; bj < 2; ++bj) { const f32x4 v0 = acc[ai][bj][m][0] * rs, v1 = acc[ai][bj][m][1] * rs;
                        u32x4 w; w.x = cvt_pk_bf16(v0[0], v0[1]); w.y = cvt_pk_bf16(v0[2], v0[3]); w.z = cvt_pk_bf16(v1[0], v1[1]); w.w = cvt_pk_bf16(v1[2], v1[3]);
                        *(u32x4*)(rowp + bj * HALF) = w; } }
        } else {
            const int ch0 = (u.pn - 9) * 128 + wc * 32 + 8 * fq;
            f32x4 ba[2], bb[2];
#pragma unroll
            for (int n = 0; n < 2; ++n) { ba[n] = *(const f32x4*)(bgate + ch0 + 4 * n) * (-LOG2E); bb[n] = *(const f32x4*)(bgate + 1024 + ch0 + 4 * n) * (-LOG2E); }
#pragma unroll
            for (int ai = 0; ai < 2; ++ai)
#pragma unroll
                for (int m = 0; m < 4; ++m) { const int row = row0 + ai * HALF + m * 16; const float rs = rs1[row] * (-LOG2E);
                    float ra[8], gb[8];
#pragma unroll
                    for (int n = 0; n < 2; ++n)
#pragma unroll
                        for (int j = 0; j < 4; ++j) { const float ea = __builtin_amdgcn_exp2f(acc[ai][0][m][n][j] * rs + ba[n][j]); const float eb = fminf(__builtin_amdgcn_exp2f(acc[ai][1][m][n][j] * rs + bb[n][j]), 1e18f);
                            gb[4 * n + j] = __builtin_amdgcn_rcpf(1.0f + eb); ra[4 * n + j] = (1.0f + eb) * __builtin_amdgcn_rcpf(1.0f + ea); }
                    u32x4 w; w.x = cvt_pk_bf16(ra[0], ra[1]); w.y = cvt_pk_bf16(ra[2], ra[3]); w.z = cvt_pk_bf16(ra[4], ra[5]); w.w = cvt_pk_bf16(ra[6], ra[7]);
                    *(u32x4*)((char*)RAT + ((unsigned)row * 1024u + (unsigned)ch0) * 2u) = w;
                    w.x = cvt_pk_bf16(gb[0], gb[1]); w.y = cvt_pk_bf16(gb[2], gb[3]); w.z = cvt_pk_bf16(gb[4], gb[5]); w.w = cvt_pk_bf16(gb[6], gb[7]);
                    *(u32x4*)((char*)GB + ((unsigned)row * 1024u + (unsigned)ch0) * 2u) = w; }
        }
    }
};

struct EpiMerge {
    static constexpr bool PERM = true, AFTER_DRAIN = false, HAS_MID = true, INIT_ACC = false; int tmid;
    const bf16_t* RAT; const bf16_t* GB; const float* bc; bf16_t* MG;
    __device__ __forceinline__ void mid(f32x4 (&acc)[2][2][4][2], const Unit& u, int wr, int wc, int fr, int fq) const {
        const int row0_ = u.pm * BM + wr * 64 + fr, col0 = u.pn * BM + wc * 32 + 8 * fq;
        int row0 = row0_; asm volatile("" : "+v"(row0));
#pragma unroll
        for (int ai = 0; ai < 2; ++ai)
#pragma unroll
            for (int m = 0; m < 4; ++m) { const unsigned rb = ((unsigned)(row0 + ai * HALF + m * 16) * 1024u + (unsigned)col0) * 2u;
#pragma unroll
                for (int bj = 0; bj < 2; ++bj) { const u32x4 w = *(const u32x4*)((const char*)RAT + (rb + bj * HALF * 2u));
                    acc[ai][bj][m][0] *= (f32x4){bflo(w.x), bfhi(w.x), bflo(w.y), bfhi(w.y)}; acc[ai][bj][m][1] *= (f32x4){bflo(w.z), bfhi(w.z), bflo(w.w), bfhi(w.w)}; }
                asm volatile("" ::: "memory"); }
    }
    __device__ __forceinline__ void operator()(const f32x4 (&acc)[2][2][4][2], const Unit& u, int wr, int wc, int fr, int fq) const {
        const int row0_ = u.pm * BM + wr * 64 + fr, col0 = u.pn * BM + wc * 32 + 8 * fq;
        int row0 = row0_; asm volatile("" : "+v"(row0));
        f32x4 bv[2][2];
#pragma unroll
        for (int bj = 0; bj < 2; ++bj)
#pragma unroll
            for (int n = 0; n < 2; ++n) bv[bj][n] = *(const f32x4*)(bc + col0 + bj * HALF + 4 * n);
#pragma unroll
        for (int ai = 0; ai < 2; ++ai)
#pragma unroll
            for (int m = 0; m < 4; ++m) { const unsigned rb = ((unsigned)(row0 + ai * HALF + m * 16) * 1024u + (unsigned)col0) * 2u;
#pragma unroll
                for (int bj = 0; bj < 2; ++bj) { const u32x4 g = *(const u32x4*)((const char*)GB + (rb + bj * HALF * 2u));
                    const f32x4 v0 = (acc[ai][bj][m][0] + bv[bj][0]) * (f32x4){bflo(g.x), bfhi(g.x), bflo(g.y), bfhi(g.y)}, v1 = (acc[ai][bj][m][1] + bv[bj][1]) * (f32x4){bflo(g.z), bfhi(g.z), bflo(g.w), bfhi(g.w)};
                    u32x4 w; w.x = cvt_pk_bf16(v0[0], v0[1]); w.y = cvt_pk_bf16(v0[2], v0[3]); w.z = cvt_pk_bf16(v1[0], v1[1]); w.w = cvt_pk_bf16(v1[2], v1[3]);
                    *(u32x4*)((char*)MG + (rb + bj * HALF * 2u)) = w; }
                asm volatile("" ::: "memory"); }
    }
};

template <bool WRITE_BF> struct EpiRes {
    static constexpr bool PERM = false, AFTER_DRAIN = false, HAS_MID = false, INIT_ACC = true; int tmid;
    const float* xin; float* out; bf16_t* XB; float* PS;
    __device__ __forceinline__ void mid(f32x4 (&)[2][2][4][2], const Unit&, int, int, int, int) const {}
    __device__ __forceinline__ void init(f32x4 (&acc)[2][2][4][2], const Unit& u, int wr, int wc, int fr, int fq) const {
        const int row0 = u.pm * BM + wr * 64 + fr, col0 = u.pn * BM + wc * 32 + 4 * fq;
#pragma unroll
        for (int ai = 0; ai < 2; ++ai)
#pragma unroll
            for (int m = 0; m < 4; ++m) { const unsigned off = (unsigned)(row0 + ai * HALF + m * 16) * 1024u + (unsigned)col0;
#pragma unroll
                for (int bj = 0; bj < 2; ++bj)
#pragma unroll
                    for (int n = 0; n < 2; ++n) acc[ai][bj][m][n] = *(const f32x4*)((const char*)xin + (off + bj * HALF + n * 16) * 4u); }
    }
    __device__ __forceinline__ void operator()(const f32x4 (&acc)[2][2][4][2], const Unit& u, int wr, int wc, int fr, int fq) const {
        const int row0_ = u.pm * BM + wr * 64 + fr, col0 = u.pn * BM + wc * 32 + 4 * fq;
        int row0 = row0_; asm volatile("" : "+v"(row0));
#pragma unroll
        for (int ai = 0; ai < 2; ++ai)
#pragma unroll
            for (int m = 0; m < 4; ++m) { const int row = row0 + ai * HALF + m * 16; const unsigned off = (unsigned)row * 1024u + (unsigned)col0; float ss = 0.f;
#pragma unroll
                for (int bj = 0; bj < 2; ++bj)
#pragma unroll
                    for (int n = 0; n < 2; ++n) { const unsigned o = off + bj * HALF + n * 16; const f32x4 x1 = acc[ai][bj][m][n]; *(f32x4*)((char*)out + o * 4u) = x1;
                        ss += (x1[0] * x1[0] + x1[1] * x1[1]) + (x1[2] * x1[2] + x1[3] * x1[3]);
                        if (WRITE_BF) { u32x2 w; w.x = cvt_pk_bf16(x1[0], x1[1]); w.y = cvt_pk_bf16(x1[2], x1[3]); *(u32x2*)((char*)XB + o * 2u) = w; } }
                ss += __shfl_xor(ss, 16); ss += __shfl_xor(ss, 32);
                if (fq == 0) PS[(size_t)row * 16 + u.pn * 4 + wc] = ss; }
    }
};

__device__ __forceinline__ float dpp_ror1(float v) { return __builtin_bit_cast(float, __builtin_amdgcn_update_dpp(0, __builtin_bit_cast(int, v), 0x121, 0xf, 0xf, false)); }
__device__ __forceinline__ float dpp_ror15(float v) { return __builtin_bit_cast(float, __builtin_amdgcn_update_dpp(0, __builtin_bit_cast(int, v), 0x12f, 0xf, 0xf, false)); }
struct EpiUpConv {
    static constexpr bool PERM = true, AFTER_DRAIN = false, HAS_MID = false, INIT_ACC = false; int tmid;
    const float* PS; const float* cfw; const float* cfb; bf16_t* ACT; float* RAW; PG8_LAS unsigned char* hal;
    __device__ __forceinline__ void mid(f32x4 (&)[2][2][4][2], const Unit&, int, int, int, int) const {}
    __device__ __forceinline__ void operator()(f32x4 (&acc)[2][2][4][2], const Unit& u, int wr, int wc, int fr, int fq) const {
        const int row0_ = u.pm * BM + wr * 64 + fr;
        int row0 = row0_; asm volatile("" : "+v"(row0));
        const int colt = wc * 32 + 8 * fq;
#pragma unroll
        for (int ai = 0; ai < 2; ++ai)
#pragma unroll
            for (int m = 0; m < 4; ++m) { const f32x4* ps = (const f32x4*)((const char*)PS + (unsigned)(row0 + ai * HALF + m * 16) * 64u);
                const f32x4 s4 = (ps[0] + ps[1]) + (ps[2] + ps[3]); const float rs = __builtin_amdgcn_rsqf(((s4[0] + s4[1]) + (s4[2] + s4[3])) * (1.0f / 1024.0f) + 1e-6f);
#pragma unroll
                for (int bj = 0; bj < 2; ++bj) { acc[ai][bj][m][0] *= rs; acc[ai][bj][m][1] *= rs; }
                asm volatile("" : "+v"(acc[ai][0][m][0]), "+v"(acc[ai][0][m][1]), "+v"(acc[ai][1][m][0]), "+v"(acc[ai][1][m][1]));
                __builtin_amdgcn_sched_barrier(0); }
        if (wr == 0) { if (fr < 2) {
#pragma unroll
            for (int bj = 0; bj < 2; ++bj)
#pragma unroll
                for (int n = 0; n < 2; ++n) *(f32x4*)((char*)RAW + ((unsigned)(u.pm * 4 + fr) * 5632u + (unsigned)(u.pn * BM + bj * HALF + colt + 4 * n)) * 4u) = acc[0][bj][0][n]; }
        } else { if (fr >= 14) {
#pragma unroll
            for (int bj = 0; bj < 2; ++bj)
#pragma unroll
                for (int n = 0; n < 2; ++n) *(f32x4*)((char*)RAW + ((unsigned)(u.pm * 4 + fr - 12) * 5632u + (unsigned)(u.pn * BM + bj * HALF + colt + 4 * n)) * 4u) = acc[1][bj][3][n]; } }
        if (fr == 0 || fr == 15) {
#pragma unroll
            for (int ai = 0; ai < 2; ++ai) { const int s = 2 * ai + wr, slot = fr ? 4 + s : s;
#pragma unroll
                for (int bj = 0; bj < 2; ++bj)
#pragma unroll
                    for (int n = 0; n < 2; ++n) *(PG8_LAS f32x4*)(hal + (slot * 256 + bj * HALF + colt + 4 * n) * 4) = (fr ? acc[ai][bj][3][n] : acc[ai][bj][0][n]); } }
        asm volatile("s_waitcnt lgkmcnt(0)" ::: "memory"); __builtin_amdgcn_s_barrier(); asm volatile("" ::: "memory");
#pragma unroll
        for (int bj = 0; bj < 2; ++bj)
#pragma unroll
            for (int n = 0; n < 2; ++n) {
                const unsigned wo = (unsigned)(bj * 2816 + u.pn * 128 + colt + 4 * n) * 4u;
                const f32x4 w0 = *(const f32x4*)((const char*)cfw + wo), w1 = *(const f32x4*)((const char*)cfw + wo + 5632u * 4u), w2 = *(const f32x4*)((const char*)cfw + wo + 2u * 5632u * 4u), bb = *(const f32x4*)((const char*)cfb + wo);
#pragma unroll
                for (int ai = 0; ai < 2; ++ai) { const int s = 2 * ai + wr;
                    f32x4 hp = (f32x4){0.f, 0.f, 0.f, 0.f}, hn = (f32x4){0.f, 0.f, 0.f, 0.f};
                    if (s > 0) hp = *(const PG8_LAS f32x4*)(hal + ((4 + s - 1) * 256 + bj * HALF + colt + 4 * n) * 4);
                    if (s < 3) hn = *(const PG8_LAS f32x4*)(hal + ((s + 1) * 256 + bj * HALF + colt + 4 * n) * 4);
                    asm volatile("" : "+v"(acc[ai][bj][0][n]), "+v"(acc[ai][bj][1][n]), "+v"(acc[ai][bj][2][n]), "+v"(acc[ai][bj][3][n]));
                    f32x4 t1[4], t2[4];
#pragma unroll
                    for (int m = 0; m < 4; ++m)
#pragma unroll
                        for (int j = 0; j < 4; ++j) { t1[m][j] = dpp_ror1(acc[ai][bj][m][n][j]); t2[m][j] = dpp_ror15(acc[ai][bj][m][n][j]); }
#pragma unroll
                    for (int m = 0; m < 4; ++m) { const f32x4 pv = (fr == 0) ? (m == 0 ? hp : t1[m > 0 ? m - 1 : 0]) : t1[m], nv = (fr == 15) ? (m == 3 ? hn : t2[m < 3 ? m + 1 : 3]) : t2[m];
                        acc[ai][bj][m][n] = bb + w0 * pv + w1 * acc[ai][bj][m][n] + w2 * nv; }
                    asm volatile("" : "+v"(acc[ai][bj][0][n]), "+v"(acc[ai][bj][1][n]), "+v"(acc[ai][bj][2][n]), "+v"(acc[ai][bj][3][n]));
                    __builtin_amdgcn_sched_barrier(0); } }
#pragma unroll
        for (int ai = 0; ai < 2; ++ai)
#pragma unroll
            for (int m = 0; m < 4; ++m) { float o[8];
                asm volatile("" : "+v"(acc[ai][0][m][0]), "+v"(acc[ai][0][m][1]), "+v"(acc[ai][1][m][0]), "+v"(acc[ai][1][m][1]));
#pragma unroll
                for (int n = 0; n < 2; ++n)
#pragma unroll
                    for (int j = 0; j < 4; ++j) { const float g = acc[ai][0][m][n][j], v = acc[ai][1][m][n][j]; const float u2 = g * (1.5957691216057308f + 0.07135481627f * g * g);
                        o[4 * n + j] = g * __builtin_amdgcn_rcpf(1.0f + __builtin_amdgcn_exp2f(-LOG2E * u2)) * v; }
                u32x4 w; w.x = cvt_pk_bf16(o[0], o[1]); w.y = cvt_pk_bf16(o[2], o[3]); w.z = cvt_pk_bf16(o[4], o[5]); w.w = cvt_pk_bf16(o[6], o[7]);
                *(u32x4*)((char*)ACT + ((unsigned)(row0 + ai * HALF + m * 16) * 2816u + (unsigned)(u.pn * 128 + colt)) * 2u) = w;
                __builtin_amdgcn_sched_barrier(0); }
    }
};
template <class Epi, class Sched, bool ALIGN_EPI = false, bool SP2 = false>
__device__ __forceinline__ void gemm_phase(PG8_LAS unsigned char* lds, const Gemm g, const Sched& S, const Epi& E) {
    const int tid = threadIdx.x, wid = __builtin_amdgcn_readfirstlane(tid >> 6), lane = tid & 63, wr = wid >> 2, wc = wid & 3, fr = lane & 15, fq = lane >> 4;
    const int K = g.K, nt = K / BK;
    unsigned voffA[2], voffB[2];
#pragma unroll
    for (int i = 0; i < 2; ++i) { int R, C; stage_rc(tid * 16 + i * 8192, R, C); const int Rb = Epi::PERM ? ((R & ~31) + perm32(R & 31)) : R;
        voffA[i] = (unsigned)(R * K + C) * 2u; voffB[i] = (unsigned)(Rb * K + C) * 2u; }
    const size_t kstep = (size_t)(BK * 2);
    const size_t hstep = (size_t)HALF * K * 2;
    const size_t tstep = 2 * hstep;
    const unsigned ldsw = (unsigned)wid * 1024u;
    const int aoff = lds_byte(wr * 64 + fr, fq * 8), boff = lds_byte(wc * 32 + fr, fq * 8);
#define PG8_SA(b, h) (((b) * 2 + (h)) * HTB)
#define PG8_SB(b, h) ((4 + (b) * 2 + (h)) * HTB)
#define PG8_STAGE(bufoff, gbase, voff) do { _Pragma("unroll") for (int _i = 0; _i < 2; ++_i) \
        __builtin_amdgcn_global_load_lds((const unsigned*)((const char*)(gbase) + (voff)[_i]), (PG8_LAS unsigned*)(lds + (bufoff) + ldsw + _i * 8192), 16, 0, 0); } while (0)
#define PG8_LDA(dst, b, h) do { _Pragma("unroll") for (int m = 0; m < 4; ++m) _Pragma("unroll") for (int k = 0; k < 2; ++k) dst[m][k] = *(const PG8_LAS bf16x8*)(lds + PG8_SA(b, h) + aoff + m * 2048 + k * 1024); } while (0)
#define PG8_LDB(dst, b, h) do { _Pragma("unroll") for (int n = 0; n < 2; ++n) _Pragma("unroll") for (int k = 0; k < 2; ++k) dst[n][k] = *(const PG8_LAS bf16x8*)(lds + PG8_SB(b, h) + boff + n * 2048 + k * 1024); } while (0)
#define PG8_MMA(ai, bj, At, Bt) do { __builtin_amdgcn_s_setprio(1); _Pragma("unroll") for (int m = 0; m < 4; ++m) _Pragma("unroll") for (int n = 0; n < 2; ++n) _Pragma("unroll") for (int k = 0; k < 2; ++k) \
        acc[ai][bj][m][n] = __builtin_amdgcn_mfma_f32_16x16x32_bf16(Bt[n][k], At[m][k], acc[ai][bj][m][n], 0, 0, 0); __builtin_amdgcn_s_setprio(0); } while (0)
#define PG8_WAIT_V(n) asm volatile("s_waitcnt vmcnt(" #n ")" ::: "memory")
#define PG8_WAIT_L(n) asm volatile("s_waitcnt lgkmcnt(" #n ")" ::: "memory")
#define PG8_BAR __builtin_amdgcn_s_barrier()
#define PG8_SCHED __builtin_amdgcn_sched_barrier(0)
    Unit cur, nxt; int ui = 0;
    if (!S.next(0, cur)) return;
    f32x4 acc[2][2][4][2];
    if constexpr (Epi::INIT_ACC) E.init(acc, cur, wr, wc, fr, fq);
    else {
#pragma unroll
    for (int a = 0; a < 2; ++a)
#pragma unroll
        for (int b = 0; b < 2; ++b)
#pragma unroll
            for (int m = 0; m < 4; ++m)
#pragma unroll
                for (int n = 0; n < 2; ++n) acc[a][b][m][n] = (f32x4){0.f, 0.f, 0.f, 0.f};
    }
    bf16x8 At[4][2], B0[2][2], B1[2][2];
    const char* cA = (const char*)g.A + (size_t)cur.pm * tstep; const char* cB = (const char*)g.Bt + (size_t)cur.pn * tstep;
    S.a_ready(cur);
    if constexpr (SP2) {
        PG8_STAGE(PG8_SB(0, 0), cB, voffB); PG8_STAGE(PG8_SB(0, 1), cB + hstep, voffB); PG8_STAGE(PG8_SA(0, 0), cA, voffA); PG8_STAGE(PG8_SA(0, 1), cA + hstep, voffA);
        if (wr == 1) PG8_BAR;
        PG8_WAIT_V(2); PG8_BAR;
        PG8_STAGE(PG8_SB(1, 0), cB + kstep, voffB); PG8_STAGE(PG8_SA(1, 0), cA + kstep, voffA); PG8_STAGE(PG8_SB(1, 1), cB + hstep + kstep, voffB);
        PG8_WAIT_V(6); PG8_BAR;
    } else {
        PG8_STAGE(PG8_SB(0, 0), cB, voffB); PG8_STAGE(PG8_SA(0, 0), cA, voffA); PG8_STAGE(PG8_SB(0, 1), cB + hstep, voffB); PG8_STAGE(PG8_SA(0, 1), cA + hstep, voffA);
        if (wr == 1) PG8_BAR;
        PG8_WAIT_V(4); PG8_BAR;
        PG8_STAGE(PG8_SB(1, 0), cB + kstep, voffB); PG8_STAGE(PG8_SA(1, 0), cA + kstep, voffA); PG8_STAGE(PG8_SB(1, 1), cB + hstep + kstep, voffB);
        PG8_WAIT_V(6); PG8_BAR;
    }
    for (;;) {
        const bool has_next = S.next(ui + 1, nxt);
        const char* nA = has_next ? (const char*)g.A + (size_t)nxt.pm * tstep : cA; const char* nB = has_next ? (const char*)g.Bt + (size_t)nxt.pn * tstep : cB;
#pragma unroll 1
        for (int part = 0; part < (Epi::HAS_MID ? 2 : 1); ++part) {
        const int tb_ = (Epi::HAS_MID && part == 1) ? E.tmid : 0, te_ = (Epi::HAS_MID && part == 0) ? E.tmid : nt;
#pragma unroll 1
        for (int t = tb_; t < te_; t += 2) {
            const bool last = (t == nt - 2);
            const char* a1 = cA + (size_t)(t + 1) * kstep;
            const char* a2 = last ? nA : cA + (size_t)(t + 2) * kstep; const char* b2 = last ? nB : cB + (size_t)(t + 2) * kstep;
            const char* a3 = a2 + kstep; const char* b3 = b2 + kstep;
            if (last && has_next) S.a_ready(nxt);
            if constexpr (SP2) {
            PG8_LDB(B0, 0, 0); PG8_LDB(B1, 0, 1); PG8_SCHED; PG8_LDA(At, 0, 0); PG8_STAGE(PG8_SA(1, 1), a1 + hstep, voffA);
            PG8_WAIT_V(8); PG8_WAIT_L(0); PG8_BAR; PG8_MMA(0, 0, At, B0); PG8_MMA(0, 1, At, B1); PG8_BAR; PG8_SCHED;
            PG8_LDA(At, 0, 1); PG8_STAGE(PG8_SB(0, 0), b2, voffB); PG8_STAGE(PG8_SB(0, 1), b2 + hstep, voffB); PG8_STAGE(PG8_SA(0, 0), a2, voffA);
            PG8_WAIT_V(8); PG8_WAIT_L(0); PG8_BAR; PG8_MMA(1, 0, At, B0); PG8_MMA(1, 1, At, B1); PG8_BAR; PG8_SCHED;
            PG8_LDB(B0, 1, 0); PG8_LDB(B1, 1, 1); PG8_SCHED; PG8_LDA(At, 1, 0); PG8_STAGE(PG8_SA(0, 1), a2 + hstep, voffA);
            PG8_WAIT_V(8); PG8_WAIT_L(0); PG8_BAR; PG8_MMA(0, 0, At, B0); PG8_MMA(0, 1, At, B1); PG8_BAR; PG8_SCHED;
            PG8_LDA(At, 1, 1); PG8_STAGE(PG8_SB(1, 0), b3, voffB); PG8_STAGE(PG8_SB(1, 1), b3 + hstep, voffB); PG8_STAGE(PG8_SA(1, 0), a3, voffA);
            PG8_WAIT_V(8); PG8_WAIT_L(0); PG8_BAR; PG8_MMA(1, 0, At, B0); PG8_MMA(1, 1, At, B1); PG8_BAR; PG8_SCHED;
            } else {
            PG8_LDB(B0, 0, 0); PG8_SCHED; PG8_LDA(At, 0, 0); PG8_STAGE(PG8_SA(1, 1), a1 + hstep, voffA);
            PG8_WAIT_L(8); PG8_BAR; PG8_WAIT_L(0); PG8_MMA(0, 0, At, B0); PG8_BAR; PG8_SCHED;
            PG8_LDB(B1, 0, 1); PG8_STAGE(PG8_SB(0, 0), b2, voffB);
            PG8_BAR; PG8_WAIT_L(0); PG8_MMA(0, 1, At, B1); PG8_BAR;
            PG8_LDA(At, 0, 1); PG8_STAGE(PG8_SA(0, 0), a2, voffA);
            PG8_BAR; PG8_WAIT_L(0); PG8_MMA(1, 0, At, B0); PG8_BAR; PG8_SCHED;
            PG8_STAGE(PG8_SB(0, 1), b2 + hstep, voffB);
            PG8_WAIT_V(6); PG8_BAR; PG8_MMA(1, 1, At, B1); PG8_BAR;
            PG8_LDB(B0, 1, 0); PG8_SCHED; PG8_LDA(At, 1, 0); PG8_STAGE(PG8_SA(0, 1), a2 + hstep, voffA);
            PG8_WAIT_L(8); PG8_BAR; PG8_WAIT_L(0); PG8_MMA(0, 0, At, B0); PG8_BAR; PG8_SCHED;
            PG8_LDB(B1, 1, 1); PG8_STAGE(PG8_SB(1, 0), b3, voffB);
            PG8_BAR; PG8_WAIT_L(0); PG8_MMA(0, 1, At, B1); PG8_BAR;
            PG8_LDA(At, 1, 1); PG8_STAGE(PG8_SA(1, 0), a3, voffA);
            PG8_BAR; PG8_WAIT_L(0); PG8_MMA(1, 0, At, B0); PG8_BAR; PG8_SCHED;
            PG8_STAGE(PG8_SB(1, 1), b3 + hstep, voffB);
            PG8_WAIT_V(6); PG8_BAR; PG8_MMA(1, 1, At, B1); PG8_BAR;
            }
        }
        if constexpr (Epi::HAS_MID) { if (part == 0) E.mid(acc, cur, wr, wc, fr, fq); }
        }
        if constexpr (ALIGN_EPI) { if (wr == 0) PG8_BAR; }
        if constexpr (!Epi::AFTER_DRAIN) { E(acc, cur, wr, wc, fr, fq); S.done(cur); }
        if (!has_next) break;
        if constexpr (Epi::INIT_ACC) E.init(acc, nxt, wr, wc, fr, fq);
        else {
#pragma unroll
        for (int a = 0; a < 2; ++a)
#pragma unroll
            for (int b = 0; b < 2; ++b)
#pragma unroll
                for (int m = 0; m < 4; ++m)
#pragma unroll
                    for (int n = 0; n < 2; ++n) acc[a][b][m][n] = (f32x4){0.f, 0.f, 0.f, 0.f};
        }
        cur = nxt; cA = nA; cB = nB; ++ui;
        if constexpr (ALIGN_EPI) { if (wr == 1) PG8_BAR; }
    }
    PG8_WAIT_V(0);
    if constexpr (!ALIGN_EPI) { if (wr == 0) PG8_BAR; }
    PG8_BAR;
    if constexpr (Epi::AFTER_DRAIN) { E.fused(acc, cur, wr, wc, fr, fq, lds, wid, lane); S.done(cur); }
#undef PG8_SA
#undef PG8_SB
#undef PG8_STAGE
#undef PG8_LDA
#undef PG8_LDB
#undef PG8_MMA
#undef PG8_WAIT_V
#undef PG8_WAIT_L
#undef PG8_BAR
#undef PG8_SCHED
}
}
#ifndef PG8_SP2
#define PG8_SP2 true
#endif
#ifndef PG8_ALIGN
#define PG8_ALIGN true
#endif
constexpr int NWAVES = 8;
constexpr int N_LAUNCHES = MK_N_LAUNCHES;
constexpr int N_PHASES = 11;
constexpr int NB = 4, S = 8192, D = 1024, M = NB * S;
constexpr int LW = 1280, NH = 10, HD = 128, PW = 1024, INW = 4352, FF = 2816, FF2 = 5632, KM = LW + PW  ;
constexpr float EPS = 1e-6f;
constexpr int SEG = 16, NSEG = S / SEG;
constexpr int TC = 256, NCHUNK = S / TC;
constexpr size_t MiB = 1u << 20;
constexpr size_t WS_CTL = 0, CTL_ZERO_BYTES = 64 * 1024;
constexpr size_t OFF_WIN = 1 * MiB;
constexpr size_t OFF_WUP = 10 * MiB;
constexpr size_t OFF_WD = 21 * MiB;
constexpr size_t OFF_BT2 = 27 * MiB;
constexpr size_t OFF_WO = 32 * MiB;
constexpr size_t OFF_WG = 34 * MiB;
constexpr size_t OFF_RS1 = 36 * MiB;
constexpr size_t OFF_BC = OFF_RS1 + 128 * 1024;
constexpr size_t OFF_LAMC = OFF_BC + 4096;
constexpr size_t OFF_PS2 = 38 * MiB;
constexpr size_t OFF_PS3 = 40 * MiB;
constexpr size_t OFF_UA = 48 * MiB;
constexpr size_t OFF_X1B = 48 * MiB;
constexpr size_t OFF_UB = 128 * MiB;
constexpr size_t OFF_MG = 128 * MiB;
constexpr size_t OFF_RAT = 192 * MiB;
constexpr size_t OFF_GB = 256 * MiB;
constexpr size_t OFF_HP = 320 * MiB;
constexpr size_t OFF_XB = 448 * MiB;
constexpr size_t OFF_RAW = 112 * MiB;
constexpr size_t OFF_ACT = 288 * MiB;
constexpr size_t WS_NEED = 512 * MiB;
constexpr size_t DO_CAR = 0, DO_HIN = 40 * MiB;
constexpr int CW_TMO = 0, CW_BAR = 4096;
constexpr int RING_OFF = 0, RING_BYTES = 131072;
constexpr int LDSCTL_OFF = RING_BYTES, MISC_OFF = LDSCTL_OFF + 320;
constexpr int HALO_OFF = 135168;
constexpr int LDS_BYTES = 147456;
enum { I_X = 0, I_GMIX, I_WIN, I_BGATE, I_CAW, I_CAB, I_WAF, I_BAF, I_WXF, I_BXF, I_LAMF, I_WAB, I_BAB, I_WXB, I_BXB, I_LAMB,
       I_WPOOL, I_BPOOL, I_PSCALE, I_PA, I_PB, I_WOUT, I_GFFN, I_WUP, I_CFW, I_CFB, I_WDOWN, I_GFINAL, N_IN };

#define GAS __attribute__((address_space(1)))
#define LAS __attribute__((address_space(3)))
typedef unsigned short bf16;
typedef unsigned v4u __attribute__((ext_vector_type(4)));
typedef float f32x4 __attribute__((ext_vector_type(4)));
typedef float f32x2 __attribute__((ext_vector_type(2)));
typedef float f32x16 __attribute__((ext_vector_type(16)));
typedef short bf16x8 __attribute__((ext_vector_type(8)));
typedef GAS unsigned gu32;
#define RLX_AGENT __ATOMIC_RELAXED, __HIP_MEMORY_SCOPE_AGENT
#define LDS_WAIT() asm volatile("s_waitcnt lgkmcnt(0)" ::: "memory")
#define VM_WAIT() asm volatile("s_waitcnt vmcnt(0)" ::: "memory")
__device__ __forceinline__ unsigned f2bf(float f) { unsigned u = __builtin_bit_cast(unsigned, f); return (u + 0x7fffu + ((u >> 16) & 1u)) >> 16; }
__device__ __forceinline__ unsigned pk2(float lo, float hi) { return f2bf(lo) | (f2bf(hi) << 16); }
__device__ __forceinline__ float bflo(unsigned w) { return __uint_as_float(w << 16); }
__device__ __forceinline__ float bfhi(unsigned w) { return __uint_as_float(w & 0xffff0000u); }
constexpr float LOG2E = 1.4426950408889634f;
#define XB_TMO      128
#define XB_XCNT(j)  (256  + 64 * (j))
#define XB_XSUB(j)  (1280 + 64 * (j))
#define XB_XGEN(j)  (2304 + 64 * (j))
#define XB_TOP      3328
#define XB_TOPGEN   3392
#define XCD_BAR_WORDS 3456
#define XB_SPIN_CAP (1u << 18)

__device__ __forceinline__ unsigned xb_ld(unsigned* p)              { return __hip_atomic_load(p, __ATOMIC_RELAXED, __HIP_MEMORY_SCOPE_AGENT); }
__device__ __forceinline__ unsigned xb_add(unsigned* p, unsigned v) { return __hip_atomic_fetch_add(p, v, __ATOMIC_RELAXED, __HIP_MEMORY_SCOPE_AGENT); }
__device__ __forceinline__ unsigned xb_xcc_id() { return (unsigned)__builtin_amdgcn_s_getreg((3 << 11) | 20) & 0xFu; }
#define XB_SPIN(cond, bar) do { unsigned _sp = 0; while (cond) { __builtin_amdgcn_s_sleep(1); \
    if ((++_sp & 255u) == 0u) { if (xb_ld(&(bar)[XB_TMO])) break; if (_sp > XB_SPIN_CAP) { atomicAdd(&(bar)[XB_TMO], 1u); break; } } } } while (0)

struct XcdBarrier {
    unsigned* bar; unsigned x;
    volatile LAS unsigned* st;
};

__device__ __forceinline__ XcdBarrier xcd_barrier_post(unsigned* bar, volatile LAS unsigned* st) {
    XcdBarrier b; b.bar = bar; b.x = xb_xcc_id(); b.st = st;
    if (threadIdx.x == 0) (void)xb_add(&bar[XB_XCNT(b.x)], 1u);
    return b;
}
__device__ __forceinline__ void xcd_barrier_complete(unsigned* bar, unsigned x, unsigned& nloc, unsigned& nx) {
    const unsigned G = gridDim.x * gridDim.y * gridDim.z;
    unsigned sum, cnt, mine, sp = 0u;
    for (;;) {
        sum = 0u; cnt = 0u; mine = 0u;
#pragma unroll
        for (unsigned j = 0; j < 16; ++j) { const unsigned c = xb_ld(&bar[XB_XCNT(j)]); sum += c; cnt += (c > 0u) ? 1u : 0u; mine = (j == x) ? c : mine; }
        if (sum == G) break;
        __builtin_amdgcn_s_sleep(1);
        if ((++sp & 255u) == 0u) { if (xb_ld(&bar[XB_TMO])) break; if (sp > XB_SPIN_CAP) { atomicAdd(&bar[XB_TMO], 1u); break; } }
    }
    nloc = mine > 0u ? mine : 1u; nx = cnt > 0u ? cnt : 1u;
}

__device__ __forceinline__ void xcd_barrier(const XcdBarrier& b) {
    asm volatile("s_waitcnt vmcnt(0)" ::: "memory");
    __syncthreads();
    if (threadIdx.x == 0) {
        unsigned* bar = b.bar;
        __builtin_amdgcn_s_waitcnt(0);
        unsigned nloc = b.st[0], nx = b.st[1];
        if (nloc == 0u) { xcd_barrier_complete(bar, b.x, nloc, nx); b.st[0] = nloc; b.st[1] = nx; }
        const unsigned old = xb_add(&bar[XB_XSUB(b.x)], 1u);
        const unsigned gen = old / nloc;
        if (old + 1u == (gen + 1u) * nloc) {
            __builtin_amdgcn_fence(__ATOMIC_RELEASE, "agent");
            asm volatile("s_waitcnt vmcnt(0)" ::: "memory");
            const unsigned og = xb_add(&bar[XB_TOP], 1u);
            const unsigned tg = og / nx;
            if (og + 1u == (tg + 1u) * nx) xb_add(&bar[XB_TOPGEN], 1u);
            else XB_SPIN(xb_ld(&bar[XB_TOPGEN]) == tg, bar);
            __builtin_amdgcn_fence(__ATOMIC_ACQUIRE, "agent");
            xb_add(&bar[XB_XGEN(b.x)], 1u);
            asm volatile("s_waitcnt vmcnt(0)" ::: "memory");
        } else {
            XB_SPIN(xb_ld(&bar[XB_XGEN(b.x)]) == gen, bar);
            __builtin_amdgcn_fence(__ATOMIC_ACQUIRE, "agent");
            asm volatile("s_waitcnt vmcnt(0)" ::: "memory");
        }
    }
    __syncthreads();
}
struct Frame {
    LAS unsigned char* lds;
    volatile LAS unsigned* MISC;
    gu32* ctl;
    int tid, lane, wave;
    int vcu, G;
    const float* in[N_IN];
    float* out; unsigned char* ws;
};
__device__ __forceinline__ float wave_sum(float v) {
#pragma unroll
    for (int o = 1; o < 64; o <<= 1) v += __shfl_xor(v, o);
    return v;
}

__device__ __forceinline__ void p0_transpose_item(const float* W, int N, const float* kscale, bf16* dst_row0  , int ldk, int k0, int n0, int swz, LAS float* scr, int lane) {
#pragma unroll 8
    for (int i = 0; i < 32; ++i) { const int kk = 2 * i + (lane >> 5); float v = W[(size_t)(k0 + kk) * N + n0 + (lane & 31)]; if (kscale) v *= kscale[k0 + kk]; scr[kk * 33 + (lane & 31)] = v; }
    LDS_WAIT(); asm volatile("" ::: "memory");
    const int c = lane & 7;
#pragma unroll
    for (int j = 0; j < 4; ++j) { const int n = (lane >> 3) + 8 * j; const LAS float* s = scr + (8 * c) * 33 + n;
        v4u o; o.x = pk2(s[0 * 33], s[1 * 33]); o.y = pk2(s[2 * 33], s[3 * 33]); o.z = pk2(s[4 * 33], s[5 * 33]); o.w = pk2(s[6 * 33], s[7 * 33]);
        int chunk = (k0 >> 3) + c; if (swz) chunk ^= (n0 + n) & 15;
        *(GAS v4u*)(dst_row0 + (size_t)n * ldk + chunk * 8) = o; }
    LDS_WAIT(); asm volatile("" ::: "memory");
}
__device__ __forceinline__ void p0_prologue(Frame& F) {
    LAS float* scr = (LAS float*)(F.lds + RING_OFF + F.wave * 16384);
    const int gw = F.vcu * NWAVES + F.wave, NGW = F.G * NWAVES;
    bf16* WinT = (bf16*)(F.ws + OFF_WIN); bf16* WupT = (bf16*)(F.ws + OFF_WUP); bf16* WdT = (bf16*)(F.ws + OFF_WD); bf16* BT2 = (bf16*)(F.ws + OFF_BT2);
    bf16* WoT = (bf16*)(F.ws + OFF_WO); bf16* WgT = (bf16*)(F.ws + OFF_WG);
    constexpr int I_IN = (D / 64) * (INW / 32), I_UP = (D / 64) * (FF2 / 32), I_DN = (FF / 64) * (D / 32), I_PAI = (LW / 64) * (D / 32), I_WOI = (D / 64) * (D / 32), I_G = NH * 4 * 2 * 4;
    constexpr int NITEMS = I_IN + I_UP + I_DN + I_PAI + I_WOI + I_G;
    for (int it = gw; it < NITEMS; it += NGW) {
        int r = it;
        if (r < I_IN) { const int nblk = INW / 32, kb = r / nblk, n0 = (r % nblk) * 32; int drow = n0;
            if (n0 >= LW + PW) { const int c2 = n0 - (LW + PW), bj = c2 >> 10, ch = c2 & 1023; drow = LW + PW + 256 * (ch >> 7) + 128 * bj + (ch & 127); }
            p0_transpose_item(F.in[I_WIN], INW, F.in[I_GMIX], WinT + (size_t)drow * D, D, 64 * kb, n0, 0, scr, F.lane); continue; } r -= I_IN;
        if (r < I_UP) { const int nblk = FF2 / 32, kb = r / nblk, n0 = (r % nblk) * 32; const int bj = n0 / FF, ch = n0 % FF; const int drow = 256 * (ch >> 7) + 128 * bj + (ch & 127);
            p0_transpose_item(F.in[I_WUP], FF2, F.in[I_GFFN], WupT + (size_t)drow * D, D, 64 * kb, n0, 0, scr, F.lane); continue; } r -= I_UP;
        if (r < I_DN) { const int nblk = D / 32, kb = r / nblk, n0 = (r % nblk) * 32;
            p0_transpose_item(F.in[I_WDOWN], D, nullptr, WdT + (size_t)n0 * FF, FF, 64 * kb, n0, 0, scr, F.lane); continue; } r -= I_DN;
        if (r < I_PAI) { const int nblk = D / 32, kb = r / nblk, n0 = (r % nblk) * 32;
            p0_transpose_item(F.in[I_PA], D, nullptr, BT2 + (size_t)n0 * KM, KM, 64 * kb, n0, 0, scr, F.lane); continue; } r -= I_PAI;
        if (r < I_WOI) { const int nblk = D / 32, kb = r / nblk, n0 = (r % nblk) * 32;
            p0_transpose_item(F.in[I_WOUT], D, nullptr, WoT + (size_t)n0 * D, D, 64 * kb, n0, 0, scr, F.lane); continue; } r -= I_WOI;
        {
            const int hd = r / 32, g = (r >> 3) & 3, kb = (r >> 2) & 1, n0 = (r & 3) * 32;
            const float* src = (g == 0 ? F.in[I_WAF] : g == 1 ? F.in[I_WXF] : g == 2 ? F.in[I_WAB] : F.in[I_WXB]) + (size_t)hd * HD * HD;
            p0_transpose_item(src, HD, nullptr, WgT + ((size_t)hd * 512 + g * 128 + n0) * HD, HD, 64 * kb, n0, 1, scr, F.lane); }
    }
    float* rs1 = (float*)(F.ws + OFF_RS1); bf16* XB = (bf16*)(F.ws + OFF_XB);
    for (int m0 = gw * 4; m0 < M; m0 += NGW * 4) {
        f32x4 v[4][4];
#pragma unroll
        for (int r = 0; r < 4; ++r) { const GAS f32x4* xr = (const GAS f32x4*)(F.in[I_X] + (size_t)(m0 + r) * D) + F.lane;
#pragma unroll
            for (int j = 0; j < 4; ++j) v[r][j] = xr[64 * j]; }
#pragma unroll
        for (int r = 0; r < 4; ++r) { float s = 0.f;
#pragma unroll
            for (int j = 0; j < 4; ++j) s += (v[r][j].x * v[r][j].x + v[r][j].y * v[r][j].y) + (v[r][j].z * v[r][j].z + v[r][j].w * v[r][j].w);
            s = wave_sum(s);
            if (F.lane == 0) rs1[m0 + r] = 1.0f / sqrtf(s * (1.0f / D) + EPS);
            GAS unsigned long long* o8 = (GAS unsigned long long*)(XB + (size_t)(m0 + r) * D) + F.lane;
#pragma unroll
            for (int j = 0; j < 4; ++j) o8[64 * j] = (unsigned long long)pk2(v[r][j].x, v[r][j].y) | ((unsigned long long)pk2(v[r][j].z, v[r][j].w) << 32); }
    }
    if (F.tid < 2 * LW / 8 && F.vcu == F.G - 1) { for (int i = F.tid; i < 2 * LW; i += 2 * LW / 8) { const float lam = (i < LW ? F.in[I_LAMF] : F.in[I_LAMB])[i % LW]; ((float*)(F.ws + OFF_LAMC))[i] = -8.0f * LOG2E * log1pf(expf(-lam)); } }
    __syncthreads();
    for (int T = F.vcu; T < 256; T += F.G) {
        const int k0 = (T >> 2) * 16, g = k0 >> 8, kk0 = k0 & 255, n0 = (T & 3) * 256;
        const float* wp = F.in[I_WPOOL] + (size_t)g * 65536 + kk0 * 256; const float* sc = F.in[I_PSCALE] + g * 256; const float* pb = F.in[I_PB] + (size_t)(g * 256) * D + n0 + 4 * F.lane;
        f32x4 acc[16];
#pragma unroll
        for (int i = 0; i < 16; ++i) acc[i] = (f32x4){0.f, 0.f, 0.f, 0.f};
#pragma unroll 4
        for (int jj = 0; jj < 32; ++jj) { const int j = 32 * F.wave + jj; const f32x4 pv = *(const GAS f32x4*)(pb + (size_t)j * D) * sc[j];
#pragma unroll
            for (int i = 0; i < 16; ++i) acc[i] += pv * wp[i * 256 + j]; }
        LAS f32x4* red = (LAS f32x4*)(F.lds + RING_OFF);
#pragma unroll
        for (int i = 0; i < 16; ++i) red[(F.wave * 16 + i) * 64 + F.lane] = acc[i];
        LDS_WAIT(); __builtin_amdgcn_s_barrier(); asm volatile("" ::: "memory");
        { const int nl = F.tid & 255, kh = F.tid >> 8; float o[8];
#pragma unroll
            for (int i = 0; i < 8; ++i) { float sm = 0.f;
#pragma unroll
                for (int v = 0; v < 8; ++v) sm += ((const LAS float*)(red + (v * 16 + 8 * kh + i) * 64 + (nl >> 2)))[nl & 3];
                o[i] = sm; }
            v4u w; w.x = pk2(o[0], o[1]); w.y = pk2(o[2], o[3]); w.z = pk2(o[4], o[5]); w.w = pk2(o[6], o[7]);
            *(GAS v4u*)(BT2 + (size_t)(n0 + nl) * KM + LW + k0 + 8 * kh) = w; }
        LDS_WAIT(); __builtin_amdgcn_s_barrier(); asm volatile("" ::: "memory");
    }
    for (int T = F.vcu; T < 16; T += F.G) {
        const float* pb = F.in[I_PB] + T * 64 + F.lane; float sm = 0.f;
#pragma unroll 16
        for (int cc = 0; cc < 128; ++cc) { const int c = 128 * F.wave + cc; sm += F.in[I_BPOOL][c] * F.in[I_PSCALE][c] * pb[(size_t)c * D]; }
        LAS float* red = (LAS float*)(F.lds + RING_OFF);
        red[F.wave * 64 + F.lane] = sm;
        LDS_WAIT(); __builtin_amdgcn_s_barrier(); asm volatile("" ::: "memory");
        if (F.tid < 64) { float t = 0.f;
#pragma unroll
            for (int v = 0; v < 8; ++v) t += red[v * 64 + F.tid];
            ((float*)(F.ws + OFF_BC))[T * 64 + F.tid] = t; }
        LDS_WAIT(); __builtin_amdgcn_s_barrier(); asm volatile("" ::: "memory");
    }
}

template <bool FINAL>
__device__ __forceinline__ void scan_phase(Frame& F) {
    const int tid = F.tid, lane = F.lane, w = F.wave, c31 = lane & 31, hi = lane >> 5;
    LAS unsigned char* xat = F.lds + RING_OFF;
    LAS unsigned char* bbuf = F.lds + RING_OFF + 65536;
    const bf16* UA = (const bf16*)(F.ws + OFF_UA); const unsigned char* WgT = F.ws + OFF_WG; const float* lamc = (const float*)(F.ws + OFF_LAMC);
    f32x2* CAR = (f32x2*)((unsigned char*)F.out + DO_CAR); const float* HIN = (const float*)((unsigned char*)F.out + DO_HIN); bf16* HP = (bf16*)(F.ws + OFF_HP);
    const int NITEM = NB * NCHUNK * NH;
    const int tau = (c31 & 3) + 4 * (c31 >> 3) + 16 * ((c31 >> 2) & 1);
    const int arow = 32 * w + tau;
    const unsigned ldsw = (unsigned)w * 1024u;
#define SC_BGLDS(hd_, q_, buf_) do { _Pragma("unroll") for (int i_ = 0; i_ < 4; ++i_) { const int p_ = tid + 512 * i_, nl_ = p_ >> 4, ch_ = p_ & 15; const int ng_ = (nl_ >> 5) * 128 + 32 * (q_) + (nl_ & 31); \
        __builtin_amdgcn_global_load_lds((const unsigned*)(WgT + ((size_t)(hd_) * 512 + ng_) * 256 + ch_ * 16), (LAS unsigned*)(bbuf + (buf_) * 32768 + i_ * 8192 + ldsw), 16, 0, 0); } } while (0)
    int cur = 0; bool first = true;
    for (int it = F.vcu; it < NITEM; it += F.G) {
        const int hd = it % NH, bc_ = it / NH, b = bc_ / NCHUNK, t0 = (bc_ % NCHUNK) * TC;
        if (first) { SC_BGLDS(hd, 0, 0); cur = 0; first = false; }
        {
            const int cc = tid & 15, tg = tid >> 4;
            const int chg = hd * HD + 8 * cc;
            f32x4 wv[4][2], cb[2];
#pragma unroll
            for (int k = 0; k < 4; ++k) { wv[k][0] = *(const GAS f32x4*)(F.in[I_CAW] + k * LW + chg); wv[k][1] = *(const GAS f32x4*)(F.in[I_CAW] + k * LW + chg + 4); }
            cb[0] = *(const GAS f32x4*)(F.in[I_CAB] + chg); cb[1] = *(const GAS f32x4*)(F.in[I_CAB] + chg + 4);
            v4u u[11];
#pragma unroll
            for (int i = 0; i < 11; ++i) { const int t = t0 + 8 * tg - 2 + i; u[i] = (v4u){0u, 0u, 0u, 0u};
                if (t >= 0 && t < S) u[i] = *(const GAS v4u*)(UA + ((size_t)b * S + t) * LW + chg); }
#pragma unroll
            for (int tt = 0; tt < 8; ++tt) { f32x4 a0 = cb[0], a1 = cb[1];
#pragma unroll
                for (int k = 0; k < 4; ++k) { const v4u x = u[tt + k];
                    a0 += wv[k][0] * (f32x4){bflo(x.x), bfhi(x.x), bflo(x.y), bfhi(x.y)}; a1 += wv[k][1] * (f32x4){bflo(x.z), bfhi(x.z), bflo(x.w), bfhi(x.w)}; }
                const int row = 8 * tg + tt; v4u o; o.x = pk2(a0[0], a0[1]); o.y = pk2(a0[2], a0[3]); o.z = pk2(a1[0], a1[1]); o.w = pk2(a1[2], a1[3]);
                *(LAS v4u*)(xat + row * 256 + ((cc ^ (row & 15)) << 4)) = o; }
        }
        VM_WAIT(); LDS_WAIT(); __builtin_amdgcn_s_barrier(); asm volatile("" ::: "memory");
        bf16x8 af[8];
#pragma unroll
        for (int ks = 0; ks < 8; ++ks) af[ks] = *(const LAS bf16x8*)(xat + arow * 256 + (((2 * ks + hi) ^ (arow & 15)) << 4));
#pragma unroll 1
        for (int q = 0; q < 4; ++q) {
            { const int itn = it + F.G; if (q < 3) SC_BGLDS(hd, q + 1, cur ^ 1); else if (itn < NITEM) SC_BGLDS(itn % NH, 0, cur ^ 1); }
            const int cl = 32 * q + c31, cg = hd * HD + cl, seg = (t0 + 32 * w + 16 * hi) / SEG;
            float xa[16];
#pragma unroll
            for (int r = 0; r < 16; ++r) { const int row = 32 * w + 16 * hi + r; xa[r] = __uint_as_float((unsigned)(*(const LAS unsigned short*)(xat + row * 256 + (((cl >> 3) ^ r) << 4) + (cl & 7) * 2)) << 16); }
            float hsum[16];
#pragma unroll
            for (int dir = 0; dir < 2; ++dir) {
                f32x16 ga, gx;
#pragma unroll
                for (int r = 0; r < 16; ++r) { ga[r] = 0.f; gx[r] = 0.f; }
#pragma unroll
                for (int ks = 0; ks < 8; ++ks) { const int na = 32 * (2 * dir) + c31, nx = na + 32;
                    const bf16x8 ba_ = *(const LAS bf16x8*)(bbuf + cur * 32768 + na * 256 + (((2 * ks + hi) ^ (na & 15)) << 4));
                    const bf16x8 bx_ = *(const LAS bf16x8*)(bbuf + cur * 32768 + nx * 256 + (((2 * ks + hi) ^ (nx & 15)) << 4));
                    ga = __builtin_amdgcn_mfma_f32_32x32x16_bf16(af[ks], ba_, ga, 0, 0, 0); gx = __builtin_amdgcn_mfma_f32_32x32x16_bf16(af[ks], bx_, gx, 0, 0, 0); }
                const float nba = -LOG2E * (dir ? F.in[I_BAB] : F.in[I_BAF])[cg], nbx = -LOG2E * (dir ? F.in[I_BXB] : F.in[I_BXF])[cg], lc2 = lamc[dir * LW + cg];
                float av[16], bv[16];
#pragma unroll
                for (int r = 0; r < 16; ++r) {
                    const float er = __builtin_amdgcn_exp2f(ga[r] * (-LOG2E) + nba), rg = __builtin_amdgcn_rcpf(1.0f + er);
                    const float a = __builtin_amdgcn_exp2f(lc2 * rg);
                    const float ei = __builtin_amdgcn_exp2f(gx[r] * (-LOG2E) + nbx), ig = __builtin_amdgcn_rcpf(1.0f + ei);
                    av[r] = a; bv[r] = __builtin_amdgcn_sqrtf(fmaxf(1.0f - a * a, 0.f)) * (ig * xa[r]); }
                if (!FINAL) {
                    float A = 1.f, Bv = 0.f;
#pragma unroll
                    for (int i = 0; i < 16; ++i) { const int r = dir ? 15 - i : i; Bv = av[r] * Bv + bv[r]; A *= av[r]; }
                    CAR[(((size_t)dir * NB + b) * NSEG + seg) * LW + cg] = (f32x2){A, Bv};
                } else {
                    float h = HIN[(((size_t)dir * NB + b) * NSEG + seg) * LW + cg];
#pragma unroll
                    for (int i = 0; i < 16; ++i) { const int r = dir ? 15 - i : i; h = av[r] * h + bv[r]; if (dir == 0) hsum[r] = h; else hsum[r] += h; }
                }
            }
            if (FINAL) {
#pragma unroll
                for (int r = 0; r < 16; ++r) { const int row = 32 * w + 16 * hi + r; *(LAS unsigned short*)(xat + row * 256 + (((cl >> 3) ^ r) << 4) + (cl & 7) * 2) = (unsigned short)f2bf(hsum[r]); }
            }
            VM_WAIT(); LDS_WAIT(); __builtin_amdgcn_s_barrier(); asm volatile("" ::: "memory");
            cur ^= 1;
        }
        if (FINAL) {
#pragma unroll
            for (int i = 0; i < 8; ++i) { const int p = tid + 512 * i, row = p >> 4, chs = p & 15; const v4u v = *(const LAS v4u*)(xat + row * 256 + (chs << 4));
                *(GAS v4u*)(HP + ((size_t)b * S + t0 + row) * KM + hd * HD + ((chs ^ (row & 15)) << 3)) = v; }
            LDS_WAIT(); __builtin_amdgcn_s_barrier(); asm volatile("" ::: "memory");
        }
    }
#undef SC_BGLDS
}

template <int HW>
__device__ __forceinline__ void pool_item(const bf16* ub, bf16* hp, int t0) {
    constexpr int NR = 16 + 2 * HW - 1;
    v4u u[NR];
#pragma unroll
    for (int i = 0; i < NR; ++i) { const int t = t0 - HW + i; u[i] = (v4u){0u, 0u, 0u, 0u}; if (t >= 0 && t < S) u[i] = *(const GAS v4u*)(ub + (size_t)t * PW); }
    float sum[8];
#pragma unroll
    for (int j = 0; j < 8; ++j) sum[j] = 0.f;
#define PL_ACC(x_, sgn_) do { sum[0] += (sgn_) * bflo((x_).x); sum[1] += (sgn_) * bfhi((x_).x); sum[2] += (sgn_) * bflo((x_).y); sum[3] += (sgn_) * bfhi((x_).y); \
        sum[4] += (sgn_) * bflo((x_).z); sum[5] += (sgn_) * bfhi((x_).z); sum[6] += (sgn_) * bflo((x_).w); sum[7] += (sgn_) * bfhi((x_).w); } while (0)
#pragma unroll
    for (int i = 0; i < 2 * HW; ++i) PL_ACC(u[i], 1.f);
#pragma unroll
    for (int i = 0; i < 16; ++i) { const int t = t0 + i;
        const int lo = max(t - HW, 0), hi = min(t + HW - 1, S - 1); const float inv = 1.0f / (float)(hi - lo + 1);
        const v4u x = u[i + HW];
        v4u o; o.x = pk2(sum[0] * inv - bflo(x.x), sum[1] * inv - bfhi(x.x)); o.y = pk2(sum[2] * inv - bflo(x.y), sum[3] * inv - bfhi(x.y));
        o.z = pk2(sum[4] * inv - bflo(x.z), sum[5] * inv - bfhi(x.z)); o.w = pk2(sum[6] * inv - bflo(x.w), sum[7] * inv - bfhi(x.w));
        *(GAS v4u*)(hp + (size_t)t * KM) = o;
        if (i < 15) { PL_ACC(u[i + 2 * HW], 1.f); PL_ACC(u[i], -1.f); } }
#undef PL_ACC
}
__device__ __forceinline__ void carry_pool_phase(Frame& F) {
    {
        const f32x2* CAR = (const f32x2*)((unsigned char*)F.out + DO_CAR); float* HIN = (float*)((unsigned char*)F.out + DO_HIN);
        LAS f32x2* sh = (LAS f32x2*)(F.lds + RING_OFF);
        for (int task = F.vcu; task < 2 * NB * (LW / 64); task += F.G) {
            const int cgp = task % (LW / 64), db = task / (LW / 64), dir = db / NB, ss = F.tid >> 6, c = cgp * 64 + F.lane;
            const size_t base = (size_t)db * NSEG * LW + c;
            const long sstep = dir ? -(long)LW : (long)LW; const f32x2* cp = CAR + base + (size_t)(dir ? (NSEG - 1 - ss * 64) : ss * 64) * LW;
            float A = 1.f, Bv = 0.f;
#pragma unroll 16
            for (int i = 0; i < 64; ++i) { const f32x2 ab = cp[(long)i * sstep]; Bv = ab.x * Bv + ab.y; A *= ab.x; }
            sh[ss * 64 + F.lane] = (f32x2){A, Bv};
            LDS_WAIT(); __builtin_amdgcn_s_barrier(); asm volatile("" ::: "memory");
            float h = 0.f;
            for (int s2 = 0; s2 < ss; ++s2) { const f32x2 t = sh[s2 * 64 + F.lane]; h = t.x * h + t.y; }
            float* hp = HIN + base + (size_t)(dir ? (NSEG - 1 - ss * 64) : ss * 64) * LW;
#pragma unroll 16
            for (int i = 0; i < 64; ++i) { const f32x2 ab = cp[(long)i * sstep]; hp[(long)i * sstep] = h; h = ab.x * h + ab.y; }
            LDS_WAIT(); __builtin_amdgcn_s_barrier(); asm volatile("" ::: "memory");
        }
    }
    {
        const int gt = F.vcu * (NWAVES * 64) + F.tid, NGT = F.G * NWAVES * 64;
        for (int item = gt; item < (M / 16) * (PW / 8); item += NGT) {
            const int g = (item >> 6) & 3, cc = g * 32 + (item & 31), tb = ((item >> 8) << 1) | ((item >> 5) & 1), b = tb / (S / 16), t0 = (tb % (S / 16)) * 16;
            const bf16* ub = (const bf16*)(F.ws + OFF_UB) + (size_t)b * S * PW + cc * 8; bf16* hp = (bf16*)(F.ws + OFF_HP) + (size_t)b * S * KM + LW + cc * 8;
            if (g == 0) pool_item<1>(ub, hp, t0); else if (g == 1) pool_item<2>(ub, hp, t0); else if (g == 2) pool_item<4>(ub, hp, t0); else pool_item<8>(ub, hp, t0);
        }
    }
}

__device__ __forceinline__ void fixup_phase(Frame& F) {
    const float* RAW = (const float*)(F.ws + OFF_RAW); bf16* ACT = (bf16*)(F.ws + OFF_ACT);
    const int gt = F.vcu * (NWAVES * 64) + F.tid, NGT = F.G * NWAVES * 64;
    for (int item = gt; item < (M / 256) * 2 * (FF / 8); item += NGT) {
        const int cc = item % (FF / 8), pr = item / (FF / 8), last = pr & 1, pm = pr >> 1, ch = cc * 8, gcol = (ch >> 7) * 256 + (ch & 127);
        const float* rp = nullptr; const float* rc; const float* rn = nullptr;
        if (!last) { if (pm & 31) rp = RAW + (size_t)((pm - 1) * 4 + 3) * FF2; rc = RAW + (size_t)(pm * 4 + 0) * FF2; rn = RAW + (size_t)(pm * 4 + 1) * FF2; }
        else { rp = RAW + (size_t)(pm * 4 + 2) * FF2; rc = RAW + (size_t)(pm * 4 + 3) * FF2; if ((pm & 31) != 31) rn = RAW + (size_t)((pm + 1) * 4 + 0) * FF2; }
        f32x4 acc_[2][2];
#pragma unroll
        for (int gv = 0; gv < 2; ++gv)
#pragma unroll
            for (int hf = 0; hf < 2; ++hf) { const int oc = gv * FF + ch + 4 * hf, pc = gcol + gv * 128 + 4 * hf;
                f32x4 a = *(const GAS f32x4*)(F.in[I_CFB] + oc) + *(const GAS f32x4*)(F.in[I_CFW] + FF2 + oc) * *(const GAS f32x4*)(rc + pc);
                if (rp) a += *(const GAS f32x4*)(F.in[I_CFW] + oc) * *(const GAS f32x4*)(rp + pc);
                if (rn) a += *(const GAS f32x4*)(F.in[I_CFW] + 2 * FF2 + oc) * *(const GAS f32x4*)(rn + pc);
                acc_[gv][hf] = a; }
        float o[8];
#pragma unroll
        for (int j = 0; j < 8; ++j) { const float g = acc_[0][j >> 2][j & 3], v = acc_[1][j >> 2][j & 3]; const float u2 = g * (1.5957691216057308f + 0.07135481627f * g * g);
            o[j] = g * __builtin_amdgcn_rcpf(1.0f + __builtin_amdgcn_exp2f(-LOG2E * u2)) * v; }
        v4u w; w.x = pk2(o[0], o[1]); w.y = pk2(o[2], o[3]); w.z = pk2(o[4], o[5]); w.w = pk2(o[6], o[7]);
        *(GAS v4u*)(ACT + (size_t)(pm * 256 + (last ? 255 : 0)) * FF + ch) = w;
    }
}

__device__ __forceinline__ void final_phase(Frame& F) {
    const int gw = F.vcu * NWAVES + F.wave, NGW = F.G * NWAVES; const float* PS = (const float*)(F.ws + OFF_PS3);
    f32x4 gv[4];
#pragma unroll
    for (int j = 0; j < 4; ++j) gv[j] = ((const GAS f32x4*)F.in[I_GFINAL])[F.lane + 64 * j];
    for (int m0 = gw * 4; m0 < M; m0 += NGW * 4) {
        f32x4 v[4][4], ps[4][4];
#pragma unroll
        for (int r = 0; r < 4; ++r) { const GAS f32x4* xr = (const GAS f32x4*)(F.out + (size_t)(m0 + r) * D) + F.lane; const GAS f32x4* pr = (const GAS f32x4*)(PS + (size_t)(m0 + r) * 16);
#pragma unroll
            for (int j = 0; j < 4; ++j) { v[r][j] = xr[64 * j]; ps[r][j] = pr[j]; } }
#pragma unroll
        for (int r = 0; r < 4; ++r) { const f32x4 s4 = (ps[r][0] + ps[r][1]) + (ps[r][2] + ps[r][3]);
            const float rs = 1.0f / sqrtf(((s4[0] + s4[1]) + (s4[2] + s4[3])) * (1.0f / D) + EPS);
            GAS f32x4* xw = (GAS f32x4*)(F.out + (size_t)(m0 + r) * D) + F.lane;
#pragma unroll
            for (int j = 0; j < 4; ++j) xw[64 * j] = v[r][j] * rs * gv[j]; }
    }
}

struct Args { const float* in[N_IN]; float* out; unsigned char* ws; int ph_lo, ph_hi, li, pad; };
__global__ void __launch_bounds__(NWAVES * 64, 2) mk_fwd(Args args) {
    extern __shared__ __attribute__((aligned(16))) unsigned char lds[];
    Frame F;
    F.lds = (LAS unsigned char*)lds;
    F.MISC = (volatile LAS unsigned*)(F.lds + MISC_OFF);
    F.tid = threadIdx.x; F.lane = F.tid & 63; F.wave = __builtin_amdgcn_readfirstlane(F.tid >> 6);
    F.G = gridDim.x; { const int bx = blockIdx.x; F.vcu = (F.G % 8 == 0) ? (bx % 8) * (F.G / 8) + bx / 8 : bx; }
#pragma unroll
    for (int i = 0; i < N_IN; ++i) F.in[i] = args.in[i];
    F.out = args.out; F.ws = args.ws;
    F.ctl = (gu32*)(args.ws + WS_CTL);
    for (int u = F.tid; u < (LDS_BYTES - LDSCTL_OFF) / 4; u += NWAVES * 64) ((LAS unsigned*)(F.lds + LDSCTL_OFF))[u] = 0u;
    __syncthreads();
    XcdBarrier bar; bar.bar = (unsigned*)(F.ctl + CW_BAR); bar.x = 0; bar.st = nullptr;
    if (N_LAUNCHES == 1) bar = xcd_barrier_post((unsigned*)(F.ctl + CW_BAR), F.MISC + 8);
    const int lo = args.ph_lo, hi = args.ph_hi;
#define IN(k) (lo <= (k) && (k) < hi)
#define SEAM(k) do { if (IN(k) && IN((k) + 1)) xcd_barrier(bar); } while (0)
    unsigned char* ws = args.ws;
#ifndef SKIP0
    if (IN(0)) { p0_prologue(F); VM_WAIT(); __syncthreads(); }
#endif
    SEAM(0);
    if (IN(1)) {

        pg8::Gemm g{(const bf16*)(ws + OFF_XB), (const bf16*)(ws + OFF_WIN), M, INW, D}; pg8::StaticOrder So; So.init(M, INW, F.G, (int)blockIdx.x);
        pg8::EpiG1 E{0, (bf16*)(ws + OFF_UA), (bf16*)(ws + OFF_UB), (bf16*)(ws + OFF_RAT), (bf16*)(ws + OFF_GB), (const float*)(ws + OFF_RS1), args.in[I_BGATE]};
#ifndef SKIP1
        pg8::gemm_phase<pg8::EpiG1, pg8::StaticOrder, PG8_ALIGN, PG8_SP2>(F.lds + RING_OFF, g, So, E);
#endif
    } SEAM(1);
#ifndef SKIP2
    if (IN(2)) { scan_phase<false>(F); } SEAM(2);
#endif
#ifndef SKIP3
    if (IN(3)) { carry_pool_phase(F); } SEAM(3);
#endif
#ifndef SKIP4
    if (IN(4)) { scan_phase<true>(F); } SEAM(4);
#endif
    if (IN(5)) {

        pg8::Gemm g{(const bf16*)(ws + OFF_HP), (const bf16*)(ws + OFF_BT2), M, D, KM}; pg8::StaticOrder So; So.init(M, D, F.G, (int)blockIdx.x);
        pg8::EpiMerge E{LW / 64, (const bf16*)(ws + OFF_RAT), (const bf16*)(ws + OFF_GB), (const float*)(ws + OFF_BC), (bf16*)(ws + OFF_MG)};
#ifndef SKIP5
        pg8::gemm_phase<pg8::EpiMerge, pg8::StaticOrder, PG8_ALIGN, PG8_SP2>(F.lds + RING_OFF, g, So, E);
#endif
    } SEAM(5);
    if (IN(6)) {

        pg8::Gemm g{(const bf16*)(ws + OFF_MG), (const bf16*)(ws + OFF_WO), M, D, D}; pg8::StaticOrder So; So.init(M, D, F.G, (int)blockIdx.x);
        pg8::EpiRes<true> E{0, args.in[I_X], args.out, (bf16*)(ws + OFF_X1B), (float*)(ws + OFF_PS2)};
#ifndef SKIP6
        pg8::gemm_phase<pg8::EpiRes<true>, pg8::StaticOrder, PG8_ALIGN, PG8_SP2>(F.lds + RING_OFF, g, So, E);
#endif
    } SEAM(6);
    if (IN(7)) {
        pg8::Gemm g{(const bf16*)(ws + OFF_X1B), (const bf16*)(ws + OFF_WUP), M, FF2, D}; pg8::StaticOrder So; So.init(M, FF2, F.G, (int)blockIdx.x);
        pg8::EpiUpConv E{0, (const float*)(ws + OFF_PS2), args.in[I_CFW], args.in[I_CFB], (bf16*)(ws + OFF_ACT), (float*)(ws + OFF_RAW), F.lds + HALO_OFF};
#ifndef SKIP7
        pg8::gemm_phase<pg8::EpiUpConv, pg8::StaticOrder, true, PG8_SP2>(F.lds + RING_OFF, g, So, E);
#endif
    } SEAM(7);
#ifndef SKIP8
    if (IN(8)) { fixup_phase(F); } SEAM(8);
#endif
    if (IN(9)) {

        pg8::Gemm g{(const bf16*)(ws + OFF_ACT), (const bf16*)(ws + OFF_WD), M, D, FF}; pg8::StaticOrder So; So.init(M, D, F.G, (int)blockIdx.x);
        pg8::EpiRes<false> E{0, args.out, args.pad ? (float*)(ws + 128 * MiB) : args.out, nullptr, (float*)(ws + OFF_PS3)};
#ifndef SKIP9
        pg8::gemm_phase<pg8::EpiRes<false>, pg8::StaticOrder, PG8_ALIGN, PG8_SP2>(F.lds + RING_OFF, g, So, E);
#endif
    } SEAM(9);
#ifndef SKIP10
    if (IN(10)) { final_phase(F); }
#endif
#undef IN
#undef SEAM
}

extern "C" void kernel_launch(void* const* d_in, const int* in_sizes, int n_in, void* d_out, int out_size, void* d_ws, size_t ws_size, hipStream_t stream) {
    static int grid = 0;
    if (grid == 0) {
        if (n_in != N_IN || in_sizes[0] != M * D || out_size != M * D || ws_size < WS_NEED) { fprintf(stderr, "kernel_launch: unexpected shapes: n_in %d in0 %d out %d ws %zu; nothing launched\n", n_in, n_in > 0 ? in_sizes[0] : -1, out_size, ws_size); grid = -1; return; }
        int dev = 0, cus = 0, per_cu = 0;
        if (hipGetDevice(&dev) != hipSuccess || hipDeviceGetAttribute(&cus, hipDeviceAttributeMultiprocessorCount, dev) != hipSuccess) { grid = -1; return; }
        if (hipFuncSetAttribute((const void*)mk_fwd, hipFuncAttributeMaxDynamicSharedMemorySize, LDS_BYTES) != hipSuccess) { fprintf(stderr, "kernel_launch: hipFuncSetAttribute failed\n"); grid = -1; return; }
        if (hipOccupancyMaxActiveBlocksPerMultiprocessor(&per_cu, (const void*)mk_fwd, NWAVES * 64, LDS_BYTES) != hipSuccess || per_cu < 1) { fprintf(stderr, "kernel_launch: occupancy query says %d blocks per CU\n", per_cu); per_cu = 1; }
        (void)hipGetLastError();
        grid = cus;
    }
    if (grid < 0) return;
    if (hipMemsetAsync((char*)d_ws + WS_CTL, 0, CTL_ZERO_BYTES, stream) != hipSuccess) { fprintf(stderr, "kernel_launch: memset failed\n"); return; }
    Args a{};
    for (int i = 0; i < N_IN; ++i) a.in[i] = (const float*)d_in[i];
    a.out = (float*)d_out; a.ws = (unsigned char*)d_ws;
    if (N_LAUNCHES == 1) { a.ph_lo = 0; a.ph_hi = N_PHASES; a.li = 0; hipLaunchKernelGGL(mk_fwd, dim3(grid), dim3(NWAVES * 64), LDS_BYTES, stream, a); }
    else for (int li = 0; li < N_PHASES; ++li) { a.ph_lo = li; a.ph_hi = li + 1; a.li = li;
#ifdef PROBE_DUP
        if ((PROBE_DUP >> li) & 1) { a.pad = (li == 9); hipLaunchKernelGGL(mk_fwd, dim3(grid), dim3(NWAVES * 64), LDS_BYTES, stream, a); a.pad = 0; }
#endif
        hipLaunchKernelGGL(mk_fwd, dim3(grid), dim3(NWAVES * 64), LDS_BYTES, stream, a); }
    const hipError_t le = hipPeekAtLastError();
    if (le != hipSuccess) fprintf(stderr, "kernel_launch: launch failed: %s\n", hipGetErrorName(le));
}
```
